# Optimizing an MI355X kernel written in HIP

```python
import jax, jax.numpy as jnp
from jax import lax
import numpy as np

D_MODEL = 2048
BATCH = 2
SEQ = 4096
DEPTH = 1

CHUNK = 64
D_MIX = D_MODEL
D_ATTN = D_MIX // 2
D_POOL = D_MIX - D_ATTN
HEAD_DIM = 128
N_HEADS = D_ATTN // HEAD_DIM
POOL_WINDOWS = (2, 4, 8, 16)
N_POOL_GROUPS = len(POOL_WINDOWS)
POOL_GROUP_DIM = D_POOL // N_POOL_GROUPS
D_FF = ((8 * D_MODEL // 3 + 127) // 128) * 128
Q_BLOCK = 128
N_MOD = 9
D_IN_PROJ = 3 * D_ATTN + N_HEADS + D_POOL
EPS = 1e-6

kernel_name = "hybrid_fox_pool_macaron_block"


def _rmsnorm(x, g):
    xf = x.astype(jnp.float32)
    xf = xf * lax.rsqrt(jnp.mean(xf * xf, axis=-1, keepdims=True) + EPS)
    return xf.astype(x.dtype) * g


def _modulate(h, shift, scale):
    return h * (1.0 + scale[:, None, :]) + shift[:, None, :]


def _swiglu(h, w_in, w_out):
    a, b = jnp.split(h @ w_in, 2, axis=-1)
    return (jax.nn.silu(a) * b) @ w_out


def _forgetting_attention(q, k, v, log_f):
    S = q.shape[2]
    scale = HEAD_DIM ** -0.5
    F = jnp.cumsum(log_f, axis=-1)
    outs = []
    for i in range(S // Q_BLOCK):
        qs, qe = i * Q_BLOCK, (i + 1) * Q_BLOCK
        qb = q[:, :, qs:qe]
        kb = k[:, :, :qe]
        vb = v[:, :, :qe]
        logits = jnp.einsum('bhqd,bhkd->bhqk', qb, kb).astype(jnp.float32) * scale
        logits = logits + (F[:, :, qs:qe, None] - F[:, :, None, :qe])
        causal = (qs + jnp.arange(Q_BLOCK))[:, None] >= jnp.arange(qe)[None, :]
        logits = jnp.where(causal[None, None], logits, -jnp.inf)
        p = jax.nn.softmax(logits, axis=-1)
        outs.append(jnp.einsum('bhqk,bhkd->bhqd', p.astype(vb.dtype), vb))
    return jnp.concatenate(outs, axis=2)


def _multiscale_pool(u, pool_w, pool_scale):
    B, S, _ = u.shape
    ug = u.reshape(B, S, N_POOL_GROUPS, POOL_GROUP_DIM)
    pos = jnp.arange(S)
    pooled = []
    for g, w in enumerate(POOL_WINDOWS):
        xg = ug[:, :, g].astype(jnp.float32)
        cs0 = jnp.pad(jnp.cumsum(xg, axis=1), ((0, 0), (1, 0), (0, 0)))
        lag = jnp.pad(cs0, ((0, 0), (w - 1, 0), (0, 0)))[:, :S]
        count = jnp.minimum(pos + 1, w).astype(jnp.float32)[None, :, None]
        mean = (cs0[:, 1:] - lag) / count
        pooled.append((mean - xg).astype(u.dtype))
    p = jnp.stack(pooled, axis=2)
    p = jnp.einsum('bsgc,gcd->bsgd', p, pool_w)
    return p.reshape(B, S, D_POOL) * pool_scale


def _hybrid_mixer(h, w_in, b_forget, q_norm_g, k_norm_g, pool_w, pool_scale, w_out):
    B, S, _ = h.shape
    proj = h @ w_in
    q, k, v, f_logit, u = jnp.split(
        proj, [D_ATTN, 2 * D_ATTN, 3 * D_ATTN, 3 * D_ATTN + N_HEADS], axis=-1)

    def heads(t):
        return t.reshape(B, S, N_HEADS, HEAD_DIM).transpose(0, 2, 1, 3)

    q = _rmsnorm(heads(q), q_norm_g)
    k = _rmsnorm(heads(k), k_norm_g)
    v = heads(v)
    log_f = jax.nn.log_sigmoid((f_logit + b_forget).astype(jnp.float32)).transpose(0, 2, 1)
    attn = _forgetting_attention(q, k, v, log_f)
    attn = attn.transpose(0, 2, 1, 3).reshape(B, S, D_ATTN)
    pool = _multiscale_pool(u, pool_w, pool_scale)
    return jnp.concatenate([attn, pool], axis=-1) @ w_out


def _nrm(k, shape, scale):
    return jax.random.normal(k, shape, jnp.float32) * scale


def setup_inputs(seed: int = 0) -> dict:
    key = jax.random.key(seed)
    ks = jax.random.split(key, 20)
    L = DEPTH
    return {
        "x": _nrm(ks[0], (BATCH, SEQ, D_MODEL), 1.0),
        "c": _nrm(ks[1], (BATCH, D_MODEL), 1.0),
        "w_ada": _nrm(ks[2], (L, D_MODEL, N_MOD * D_MODEL), 0.5 * D_MODEL ** -0.5),
        "b_ada": _nrm(ks[3], (L, N_MOD * D_MODEL), 0.02),
        "ffn1_norm_g": 1.0 + _nrm(ks[4], (L, D_MODEL), 0.05),
        "ffn1_w_in": _nrm(ks[5], (L, D_MODEL, 2 * D_FF), D_MODEL ** -0.5),
        "ffn1_w_out": _nrm(ks[6], (L, D_FF, D_MODEL), D_FF ** -0.5),
        "mix_norm_g": 1.0 + _nrm(ks[7], (L, D_MODEL), 0.05),
        "w_in": _nrm(ks[8], (L, D_MODEL, D_IN_PROJ), D_MODEL ** -0.5),
        "b_forget": jax.random.uniform(ks[9], (L, N_HEADS), jnp.float32, 1.0, 4.0),
        "q_norm_g": 1.0 + _nrm(ks[10], (L, HEAD_DIM), 0.05),
        "k_norm_g": 1.0 + _nrm(ks[11], (L, HEAD_DIM), 0.05),
        "pool_w": _nrm(ks[12], (L, N_POOL_GROUPS, POOL_GROUP_DIM, POOL_GROUP_DIM), POOL_GROUP_DIM ** -0.5),
        "pool_scale": 1.0 + _nrm(ks[13], (L, D_POOL), 0.1),
        "w_out": _nrm(ks[14], (L, D_MIX, D_MODEL), D_MIX ** -0.5),
        "ffn2_norm_g": 1.0 + _nrm(ks[15], (L, D_MODEL), 0.05),
        "ffn2_w_in": _nrm(ks[16], (L, D_MODEL, 2 * D_FF), D_MODEL ** -0.5),
        "ffn2_w_out": _nrm(ks[17], (L, D_FF, D_MODEL), D_FF ** -0.5),
        "final_norm_g": 1.0 + _nrm(ks[18], (D_MODEL,), 0.05),
    }


def reference(x, c, w_ada, b_ada, ffn1_norm_g, ffn1_w_in, ffn1_w_out, mix_norm_g,
              w_in, b_forget, q_norm_g, k_norm_g, pool_w, pool_scale, w_out,
              ffn2_norm_g, ffn2_w_in, ffn2_w_out, final_norm_g):
    c_act = jax.nn.silu(c)
    for l in range(DEPTH):
        mod = c_act @ w_ada[l] + b_ada[l]
        sh1, sc1, g1, sh2, sc2, g2, sh3, sc3, g3 = jnp.split(mod, N_MOD, axis=-1)
        h = _modulate(_rmsnorm(x, ffn1_norm_g[l]), sh1, sc1)
        x = x + 0.5 * g1[:, None, :] * _swiglu(h, ffn1_w_in[l], ffn1_w_out[l])
        h = _modulate(_rmsnorm(x, mix_norm_g[l]), sh2, sc2)
        x = x + g2[:, None, :] * _hybrid_mixer(h, w_in[l], b_forget[l], q_norm_g[l], k_norm_g[l],
                                              pool_w[l], pool_scale[l], w_out[l])
        h = _modulate(_rmsnorm(x, ffn2_norm_g[l]), sh3, sc3)
        x = x + 0.5 * g3[:, None, :] * _swiglu(h, ffn2_w_in[l], ffn2_w_out[l])
    return _rmsnorm(x, final_norm_g)
```

```cpp
#include <hip/hip_runtime.h>
#include <hip/hip_cooperative_groups.h>
#include <cstdio>
#include <cstdint>
namespace cg = cooperative_groups;

namespace pg8 {
#define PG8_LAS __attribute__((address_space(3)))
typedef unsigned short bf16_t;
typedef short bf16x8 __attribute__((ext_vector_type(8)));
typedef float f32x4 __attribute__((ext_vector_type(4)));
typedef unsigned u32x4 __attribute__((ext_vector_type(4)));
constexpr int BM = 256, BK = 64, HALF = 128, HTB = HALF * BK * 2  , STAGE_BYTES = 8 * HTB, NXCD = 8, WGM = 8;

__host__ __device__ __forceinline__ int lds_byte(int r, int c) { const int st = (r >> 4) * 2 + (c >> 5), rr = r & 15, cc = c & 31, ob = rr * 64 + cc * 2; return st * 1024 + (ob ^ (((ob >> 9) & 1) << 5)); }
__host__ __device__ __forceinline__ void stage_rc(int b, int& R, int& C) { const int st = b / 1024, sb = b % 1024, swz = sb ^ (((sb >> 9) & 1) << 5); R = (st >> 1) * 16 + swz / 64; C = (st & 1) * 32 + (swz % 64) / 2; }
__host__ __device__ __forceinline__ int perm32(int rho) { const int n = rho >> 4, i = rho & 15; return 8 * (i >> 2) + 4 * n + (i & 3); }

struct Unit { int pm, pn; };
struct Gemm { const bf16_t* A; const bf16_t* Bt; int lda, ldb, K; size_t a_pn_step; };

struct StaticOrder {
    int nM, nN, nwg, G, c;
    __host__ __device__ void init(int M, int N, int G_, int c_) { nM = M / BM; nN = N / BM; nwg = nM * nN; G = G_; c = c_; }
    __host__ __device__ bool next(int i, Unit& u) const {
        const long L = (long)i * G + c; if (L >= nwg) return false;
        int wgid = (int)L; { const int q = nwg / NXCD, r = nwg % NXCD, xcd = wgid % NXCD, off = wgid / NXCD; wgid = (xcd < r ? xcd * (q + 1) : r * (q + 1) + (xcd - r) * q) + off; }
        const int nig = WGM * nN, gid = wgid / nig, fm = gid * WGM, gsz = (nM - fm) < WGM ? (nM - fm) : WGM;
        u.pm = fm + ((wgid % nig) % gsz); u.pn = (wgid % nig) / gsz; return true;
    }
    __device__ __forceinline__ void a_ready(const Unit&) const {}
    __device__ __forceinline__ void done(const Unit&) const {}
};

__device__ __forceinline__ unsigned cvt_pk_bf16(float lo, float hi) { unsigned r; asm volatile("v_cvt_pk_bf16_f32 %0, %1, %2" : "=v"(r) : "v"(lo), "v"(hi)); return r; }

struct EpiBf16 {
    static constexpr bool PERM = true, AFTER_DRAIN = false;
    bf16_t* O; int ldc; int split_cols; size_t split_stride;
    __device__ __forceinline__ void operator()(const f32x4 (&acc)[2][2][4][2], const Unit& u, int wr, int wc, int fr, int fq) const {
        const int row0 = u.pm * BM + wr * 64 + fr; int colt = u.pn * BM; bf16_t* base = O;
        if (split_cols) { const int t = colt / split_cols; base += (size_t)t * split_stride; colt -= t * split_cols; }
        const int col0 = colt + wc * 32 + 8 * fq;
#pragma unroll
        for (int ai = 0; ai < 2; ++ai)
#pragma unroll
            for (int m = 0; m < 4; ++m) { bf16_t* rowp = base + (size_t)(row0 + ai * HALF + m * 16) * ldc + col0;
#pragma unroll
                for (int bj = 0; bj < 2; ++bj) { const f32x4 v0 = acc[ai][bj][m][0], v1 = acc[ai][bj][m][1];
                    u32x4 w; w.x = cvt_pk_bf16(v0[0], v0[1]); w.y = cvt_pk_bf16(v0[2], v0[3]); w.z = cvt_pk_bf16(v1[0], v1[1]); w.w = cvt_pk_bf16(v1[2], v1[3]);
                    *(u32x4*)(rowp + bj * HALF) = w; } }
    }
};
__device__ __forceinline__ float silu_f(float a) { return a * __builtin_amdgcn_rcpf(1.0f + __builtin_amdgcn_exp2f(-1.4426950408889634f * a)); }
struct EpiSwiglu {
    static constexpr bool PERM = true, AFTER_DRAIN = false;
    bf16_t* O; int ldc;
    __device__ __forceinline__ void operator()(const f32x4 (&acc)[2][2][4][2], const Unit& u, int wr, int wc, int fr, int fq) const {
        const int row0 = u.pm * BM + wr * 64 + fr; const int col0 = u.pn * HALF + wc * 32 + 8 * fq;
#pragma unroll
        for (int ai = 0; ai < 2; ++ai)
#pragma unroll
            for (int m = 0; m < 4; ++m) { bf16_t* rowp = O + (size_t)(row0 + ai * HALF + m * 16) * ldc + col0;
                const f32x4 a0 = acc[ai][0][m][0], a1 = acc[ai][0][m][1], b0 = acc[ai][1][m][0], b1 = acc[ai][1][m][1];
                u32x4 w;
                w.x = cvt_pk_bf16(silu_f(a0[0]) * b0[0], silu_f(a0[1]) * b0[1]); w.y = cvt_pk_bf16(silu_f(a0[2]) * b0[2], silu_f(a0[3]) * b0[3]);
                w.z = cvt_pk_bf16(silu_f(a1[0]) * b1[0], silu_f(a1[1]) * b1[1]); w.w = cvt_pk_bf16(silu_f(a1[2]) * b1[2], silu_f(a1[3]) * b1[3]);
                *(u32x4*)rowp = w; }
    }
};
struct EpiResid {
    static constexpr bool PERM = false, AFTER_DRAIN = false;
    const float* base; float* out; int ldc; const float* gate; int gate_bstride; int rows_per_batch; float coef;
    __device__ __forceinline__ void operator()(const f32x4 (&acc)[2][2][4][2], const Unit& u, int wr, int wc, int fr, int fq) const {
        const int col0 = u.pn * BM + wc * 32 + 4 * fq;
        const float* gp = gate + (size_t)((u.pm * BM) / rows_per_batch) * gate_bstride + col0;
        f32x4 gv[2][2];
#pragma unroll
        for (int bj = 0; bj < 2; ++bj)
#pragma unroll
            for (int n = 0; n < 2; ++n) gv[bj][n] = *(const f32x4*)(gp + bj * HALF + n * 16) * coef;
#pragma unroll
        for (int ai = 0; ai < 2; ++ai)
#pragma unroll
            for (int m = 0; m < 4; ++m) { const size_t off = (size_t)(u.pm * BM + ai * HALF + wr * 64 + m * 16 + fr) * ldc + col0;
#pragma unroll
                for (int bj = 0; bj < 2; ++bj)
#pragma unroll
                    for (int n = 0; n < 2; ++n) { const f32x4 bs = *(const f32x4*)(base + off + bj * HALF + n * 16);
                        *(f32x4*)(out + off + bj * HALF + n * 16) = bs + gv[bj][n] * acc[ai][bj][m][n]; }
                asm volatile("" ::: "memory"); }
    }
};

template <class Epi, class Sched, bool ALIGN_EPI = false, bool SP2 = false>
__device__ __forceinline__ void gemm_phase(PG8_LAS unsigned char* lds, const Gemm g, const Sched& S, const Epi& E) {
    const int tid = threadIdx.x, wid = __builtin_amdgcn_readfirstlane(tid >> 6), lane = tid & 63, wr = wid >> 2, wc = wid & 3, fr = lane & 15, fq = lane >> 4;
    const int K = g.K, nt = K / BK;
    unsigned voffA[2], voffB[2];
#pragma unroll
    for (int i = 0; i < 2; ++i) { int R, C; stage_rc(tid * 16 + i * 8192, R, C); const int Rb = Epi::PERM ? ((R & ~31) + perm32(R & 31)) : R;
        voffA[i] = (unsigned)(R * g.lda + C) * 2u; voffB[i] = (unsigned)(Rb * g.ldb + C) * 2u; }
    const size_t kstep = (size_t)(BK * 2);
    const size_t hstepA = (size_t)HALF * g.lda * 2, hstepB = (size_t)HALF * g.ldb * 2;
    const size_t tstepA = 2 * hstepA, tstepB = 2 * hstepB;
    const unsigned ldsw = (unsigned)wid * 1024u;
    const int aoff = lds_byte(wr * 64 + fr, fq * 8), boff = lds_byte(wc * 32 + fr, fq * 8);
#define PG8_SA(b, h) (((b) * 2 + (h)) * HTB)
#define PG8_SB(b, h) ((4 + (b) * 2 + (h)) * HTB)
#define PG8_STAGE(bufoff, gbase, voff) do { _Pragma("unroll") for (int _i = 0; _i < 2; ++_i) \
        __builtin_amdgcn_global_load_lds((const unsigned*)((const char*)(gbase) + (voff)[_i]), (PG8_LAS unsigned*)(lds + (bufoff) + ldsw + _i * 8192), 16, 0, 0); } while (0)
#define PG8_LDA(dst, b, h) do { _Pragma("unroll") for (int m = 0; m < 4; ++m) _Pragma("unroll") for (int k = 0; k < 2; ++k) dst[m][k] = *(const PG8_LAS bf16x8*)(lds + PG8_SA(b, h) + aoff + m * 2048 + k * 1024); } while (0)
#define PG8_LDB(dst, b, h) do { _Pragma("unroll") for (int n = 0; n < 2; ++n) _Pragma("unroll") for (int k = 0; k < 2; ++k) dst[n][k] = *(const PG8_LAS bf16x8*)(lds + PG8_SB(b, h) + boff + n * 2048 + k * 1024); } while (0)
#define PG8_MMA(ai, bj, At, Bt) do { __builtin_amdgcn_s_setprio(1); _Pragma("unroll") for (int m = 0; m < 4; ++m) _Pragma("unroll") for (int n = 0; n < 2; ++n) _Pragma("unroll") for (int k = 0; k < 2; ++k) \
        acc[ai][bj][m][n] = __builtin_amdgcn_mfma_f32_16x16x32_bf16(Bt[n][k], At[m][k], acc[ai][bj][m][n], 0, 0, 0); __builtin_amdgcn_s_setprio(0); } while (0)
#define PG8_WAIT_V(n) asm volatile("s_waitcnt vmcnt(" #n ")" ::: "memory")
#define PG8_WAIT_L(n) asm volatile("s_waitcnt lgkmcnt(" #n ")" ::: "memory")
#define PG8_BAR __builtin_amdgcn_s_barrier()
#define PG8_SCHED __builtin_amdgcn_sched_barrier(0)
    Unit cur, nxt; int ui = 0;
    if (!S.next(0, cur)) return;
    f32x4 acc[2][2][4][2];
#pragma unroll
    for (int a = 0; a < 2; ++a)
#pragma unroll
        for (int b = 0; b < 2; ++b)
#pragma unroll
            for (int m = 0; m < 4; ++m)
#pragma unroll
                for (int n = 0; n < 2; ++n) acc[a][b][m][n] = (f32x4){0.f, 0.f, 0.f, 0.f};
    bf16x8 At[4][2], B0[2][2], B1[2][2];
    const char* cA = (const char*)g.A + (size_t)cur.pm * tstepA + (size_t)cur.pn * g.a_pn_step; const char* cB = (const char*)g.Bt + (size_t)cur.pn * tstepB;
    S.a_ready(cur);
    if constexpr (SP2) {
        PG8_STAGE(PG8_SB(0, 0), cB, voffB); PG8_STAGE(PG8_SB(0, 1), cB + hstepB, voffB); PG8_STAGE(PG8_SA(0, 0), cA, voffA); PG8_STAGE(PG8_SA(0, 1), cA + hstepA, voffA);
        if (wr == 1) PG8_BAR;
        PG8_WAIT_V(2); PG8_BAR;
        PG8_STAGE(PG8_SB(1, 0), cB + kstep, voffB); PG8_STAGE(PG8_SA(1, 0), cA + kstep, voffA); PG8_STAGE(PG8_SB(1, 1), cB + hstepB + kstep, voffB);
        PG8_WAIT_V(6); PG8_BAR;
    } else {
        PG8_STAGE(PG8_SB(0, 0), cB, voffB); PG8_STAGE(PG8_SA(0, 0), cA, voffA); PG8_STAGE(PG8_SB(0, 1), cB + hstepB, voffB); PG8_STAGE(PG8_SA(0, 1), cA + hstepA, voffA);
        if (wr == 1) PG8_BAR;
        PG8_WAIT_V(4); PG8_BAR;
        PG8_STAGE(PG8_SB(1, 0), cB + kstep, voffB); PG8_STAGE(PG8_SA(1, 0), cA + kstep, voffA); PG8_STAGE(PG8_SB(1, 1), cB + hstepB + kstep, voffB);
        PG8_WAIT_V(6); PG8_BAR;
    }
    for (;;) {
        const bool has_next = S.next(ui + 1, nxt);
        const char* nA = has_next ? (const char*)g.A + (size_t)nxt.pm * tstepA + (size_t)nxt.pn * g.a_pn_step : cA; const char* nB = has_next ? (const char*)g.Bt + (size_t)nxt.pn * tstepB : cB;
        for (int t = 0; t < nt; t += 2) {
            const bool last = (t == nt - 2);
            const char* a1 = cA + (size_t)(t + 1) * kstep;
            const char* a2 = last ? nA : cA + (size_t)(t + 2) * kstep; const char* b2 = last ? nB : cB + (size_t)(t + 2) * kstep;
            const char* a3 = a2 + kstep; const char* b3 = b2 + kstep;
            if (last && has_next) S.a_ready(nxt);
            if constexpr (SP2) {
            PG8_LDB(B0, 0, 0); PG8_LDB(B1, 0, 1); PG8_SCHED; PG8_LDA(At, 0, 0); PG8_STAGE(PG8_SA(1, 1), a1 + hstepA, voffA);
            PG8_WAIT_V(8); PG8_WAIT_L(0); PG8_BAR; PG8_MMA(0, 0, At, B0); PG8_MMA(0, 1, At, B1); PG8_BAR; PG8_SCHED;
            PG8_LDA(At, 0, 1); PG8_STAGE(PG8_SB(0, 0), b2, voffB); PG8_STAGE(PG8_SB(0, 1), b2 + hstepB, voffB); PG8_STAGE(PG8_SA(0, 0), a2, voffA);
            PG8_WAIT_V(8); PG8_WAIT_L(0); PG8_BAR; PG8_MMA(1, 0, At, B0); PG8_MMA(1, 1, At, B1); PG8_BAR; PG8_SCHED;
            PG8_LDB(B0, 1, 0); PG8_LDB(B1, 1, 1); PG8_SCHED; PG8_LDA(At, 1, 0); PG8_STAGE(PG8_SA(0, 1), a2 + hstepA, voffA);
            PG8_WAIT_V(8); PG8_WAIT_L(0); PG8_BAR; PG8_MMA(0, 0, At, B0); PG8_MMA(0, 1, At, B1); PG8_BAR; PG8_SCHED;
            PG8_LDA(At, 1, 1); PG8_STAGE(PG8_SB(1, 0), b3, voffB); PG8_STAGE(PG8_SB(1, 1), b3 + hstepB, voffB); PG8_STAGE(PG8_SA(1, 0), a3, voffA);
            PG8_WAIT_V(8); PG8_WAIT_L(0); PG8_BAR; PG8_MMA(1, 0, At, B0); PG8_MMA(1, 1, At, B1); PG8_BAR; PG8_SCHED;
            } else {
            PG8_LDB(B0, 0, 0); PG8_SCHED; PG8_LDA(At, 0, 0); PG8_STAGE(PG8_SA(1, 1), a1 + hstepA, voffA);
            PG8_WAIT_L(8); PG8_BAR; PG8_WAIT_L(0); PG8_MMA(0, 0, At, B0); PG8_BAR; PG8_SCHED;
            PG8_LDB(B1, 0, 1); PG8_STAGE(PG8_SB(0, 0), b2, voffB);
            PG8_BAR; PG8_WAIT_L(0); PG8_MMA(0, 1, At, B1); PG8_BAR;
            PG8_LDA(At, 0, 1); PG8_STAGE(PG8_SA(0, 0), a2, voffA);
            PG8_BAR; PG8_WAIT_L(0); PG8_MMA(1, 0, At, B0); PG8_BAR; PG8_SCHED;
            PG8_STAGE(PG8_SB(0, 1), b2 + hstepB, voffB);
            PG8_WAIT_V(6); PG8_BAR; PG8_MMA(1, 1, At, B1); PG8_BAR;
            PG8_LDB(B0, 1, 0); PG8_SCHED; PG8_LDA(At, 1, 0); PG8_STAGE(PG8_SA(0, 1), a2 + hstepA, voffA);
            PG8_WAIT_L(8); PG8_BAR; PG8_WAIT_L(0); PG8_MMA(0, 0, At, B0); PG8_BAR; PG8_SCHED;
            PG8_LDB(B1, 1, 1); PG8_STAGE(PG8_SB(1, 0), b3, voffB);
            PG8_BAR; PG8_WAIT_L(0); PG8_MMA(0, 1, At, B1); PG8_BAR;
            PG8_LDA(At, 1, 1); PG8_STAGE(PG8_SA(1, 0), a3, voffA);
            PG8_BAR; PG8_WAIT_L(0); PG8_MMA(1, 0, At, B0); PG8_BAR; PG8_SCHED;
            PG8_STAGE(PG8_SB(1, 1), b3 + hstepB, voffB);
            PG8_WAIT_V(6); PG8_BAR; PG8_MMA(1, 1, At, B1); PG8_BAR;
            }
        }
        if constexpr (ALIGN_EPI) { if (wr == 0) PG8_BAR; }
        if constexpr (!Epi::AFTER_DRAIN) { E(acc, cur, wr, wc, fr, fq); S.done(cur); }
        if (!has_next) break;
#pragma unroll
        for (int a = 0; a < 2; ++a)
#pragma unroll
            for (int b = 0; b < 2; ++b)
#pragma unroll
                for (int m = 0; m < 4; ++m)
#pragma unroll
                    for (int n = 0; n < 2; ++n) acc[a][b][m][n] = (f32x4){0.f, 0.f, 0.f, 0.f};
        cur = nxt; cA = nA; cB = nB; ++ui;
        if constexpr (ALIGN_EPI) { if (wr == 1) PG8_BAR; }
    }
    PG8_WAIT_V(0);
    if constexpr (!ALIGN_EPI) { if (wr == 0) PG8_BAR; }
    PG8_BAR;
    if constexpr (Epi::AFTER_DRAIN) { E.fused(acc, cur, wr, wc, fr, fq, lds, wid, lane); S.done(cur); }
#undef PG8_SA
#undef PG8_SB
#undef PG8_STAGE
#undef PG8_LDA
#undef PG8_LDB
#undef PG8_MMA
#undef PG8_WAIT_V
#undef PG8_WAIT_L
#undef PG8_BAR
#undef PG8_SCHED
}
}

constexpr int DM = 2048, NBATCH = 2, SEQ = 4096, MTOK = NBATCH * SEQ, DFF = 5504, NFF2 = 2 * DFF, DATT = 1024, NHEAD = 8, HDIM = 128;
constexpr int NMOD = 9 * DM, DINP = 3 * DATT + NHEAD + 1024, UOFF = 3 * DATT + NHEAD;
constexpr float EPS = 1e-6f;
constexpr int NTHREADS = 512, NWAVES = 8;
constexpr int LDS_BYTES = 147456;

constexpr size_t MiB = 1u << 20;
constexpr size_t WS_CTL = 0, WS_MOD = 1 * MiB, WS_LOGF = 2 * MiB, WS_F2 = 2 * MiB + 512 * 1024;
constexpr size_t WS_W1I = 4 * MiB, WS_W1O = 48 * MiB, WS_W2I = 72 * MiB, WS_W2O = 116 * MiB, WS_WIN = 140 * MiB, WS_WOUT = 156 * MiB, WS_WPOOL = 164 * MiB;
constexpr size_t WS_H = 168 * MiB, WS_ACT = 200 * MiB, WS_QRAW = 288 * MiB, WS_KRAW = 304 * MiB, WS_VRAW = 320 * MiB, WS_U = 336 * MiB;
constexpr size_t WS_QN = 352 * MiB, WS_KN = 368 * MiB, WS_VT = 384 * MiB, WS_POOLED = 400 * MiB, WS_A2 = 416 * MiB, WS_END = 448 * MiB;

#define LAS __attribute__((address_space(3)))
typedef unsigned short bf16;
typedef float f32x4 __attribute__((ext_vector_type(4)));
typedef short bf16x8 __attribute__((ext_vector_type(8)));
typedef unsigned u32x4 __attribute__((ext_vector_type(4)));
typedef unsigned u32x2 __attribute__((ext_vector_type(2)));

__device__ __forceinline__ unsigned f2bf(float f) { unsigned u = __builtin_bit_cast(unsigned, f); return (u + 0x7fffu + ((u >> 16) & 1u)) >> 16; }
__device__ __forceinline__ unsigned pk2(float lo, float hi) { return pg8::cvt_pk_bf16(lo, hi); }
__device__ __forceinline__ float bf_lo(unsigned w) { return __builtin_bit_cast(float, w << 16); }
__device__ __forceinline__ float bf_hi(unsigned w) { return __builtin_bit_cast(float, w & 0xffff0000u); }
__device__ __forceinline__ float wave_sum(float v) {
#pragma unroll
    for (int o = 1; o < 64; o <<= 1) v += __shfl_xor(v, o);
    return v;
}

__device__ __forceinline__ void p0_mod(const float* c, const float* w_ada, const float* b_ada, float* mod, LAS float* lds, int G, int blk, int tid) {
    LAS float* ca = lds; LAS float* red = lds + 4096;
    for (int i = tid; i < 2 * DM; i += NTHREADS) { const float v = c[i]; ca[i] = v / (1.f + __expf(-v)); }
    __syncthreads();
    const int cgp = tid % 18, rg = tid / 18;
    for (int ch = blk; ch < NMOD / 72; ch += G) {
        f32x4 a0 = {0.f, 0.f, 0.f, 0.f}, a1 = {0.f, 0.f, 0.f, 0.f};
        if (tid < 504) {
            const float* wp = w_ada + (size_t)72 * ch + 4 * cgp;
#pragma unroll 4
            for (int k = rg; k < DM; k += 28) { const f32x4 w = *(const f32x4*)(wp + (size_t)k * NMOD); const float s0 = ca[k], s1 = ca[DM + k]; a0 += w * s0; a1 += w * s1; }
            LAS float* r = red + (rg * 18 + cgp) * 8;
            *(LAS f32x4*)r = a0; *(LAS f32x4*)(r + 4) = a1;
        }
        __syncthreads();
        if (tid < 144) { const int b = tid / 72, n = tid % 72; float s = 0.f;
            for (int r = 0; r < 28; ++r) s += red[(r * 18 + (n >> 2)) * 8 + b * 4 + (n & 3)];
            mod[b * NMOD + 72 * ch + n] = s + b_ada[72 * ch + n]; }
        __syncthreads();
    }
}
__device__ __forceinline__ void transpose_item(const float* W, int ldw, int coff, bf16* WT, int ldt, int r0, int k0, int n0, const float* nscale, LAS float* scr, int lane) {
#pragma unroll 8
    for (int i = 0; i < 32; ++i) { const int kk = 2 * i + (lane >> 5); scr[kk * 33 + (lane & 31)] = W[(size_t)(k0 + kk) * ldw + coff + n0 + (lane & 31)]; }
    asm volatile("s_waitcnt lgkmcnt(0)" ::: "memory");
    const int c = lane & 7;
#pragma unroll
    for (int j = 0; j < 4; ++j) { const int n = (lane >> 3) + 8 * j; const LAS float* s = scr + (8 * c) * 33 + n;
        const float sc = nscale ? nscale[n0 + n] : 1.f;
        u32x4 o; o.x = pk2(s[0 * 33] * sc, s[1 * 33] * sc); o.y = pk2(s[2 * 33] * sc, s[3 * 33] * sc); o.z = pk2(s[4 * 33] * sc, s[5 * 33] * sc); o.w = pk2(s[6 * 33] * sc, s[7 * 33] * sc);
        *(u32x4*)(WT + (size_t)(r0 + n) * ldt + k0 + 8 * c) = o; }
    asm volatile("s_waitcnt lgkmcnt(0)" ::: "memory");
}
struct Ptrs {
    const float* in[19]; float* out; unsigned char* ws;
};
__device__ __forceinline__ void p0_convert(const Ptrs& P, LAS float* scr, int gw, int NGW, int lane) {
    bf16* W1I = (bf16*)(P.ws + WS_W1I); bf16* W1O = (bf16*)(P.ws + WS_W1O); bf16* W2I = (bf16*)(P.ws + WS_W2I); bf16* W2O = (bf16*)(P.ws + WS_W2O);
    bf16* WIN = (bf16*)(P.ws + WS_WIN); bf16* WOUT = (bf16*)(P.ws + WS_WOUT); bf16* WPOOL = (bf16*)(P.ws + WS_WPOOL);
    constexpr int I_FI = (DM / 64) * (NFF2 / 32), I_FO = (DFF / 64) * (DM / 32), I_QKV = (DM / 64) * (3 * DATT / 32), I_U = (DM / 64) * (1024 / 32), I_WO = (DM / 64) * (DM / 32), I_PW = 4 * (256 / 64) * (256 / 32);
    constexpr int NITEMS = 2 * I_FI + 2 * I_FO + I_QKV + I_U + I_WO + I_PW;
    for (int it = gw; it < NITEMS; it += NGW) {
        int r = it;
        if (r < 2 * I_FI) { const int which = r / I_FI; r -= which * I_FI; const int nblk = NFF2 / 32, kb = r / nblk, nb = r % nblk, n0 = 32 * nb;
            const int j = n0 < DFF ? n0 : n0 - DFF; const int r0 = 256 * (j / 128) + (n0 < DFF ? 0 : 128) + (j % 128);
            transpose_item(P.in[which ? 16 : 5] + n0, NFF2, 0, which ? W2I : W1I, DM, r0, 64 * kb, 0, nullptr, scr, lane);
            continue; }
        r -= 2 * I_FI;
        if (r < 2 * I_FO) { const int which = r / I_FO; r -= which * I_FO; const int nblk = DM / 32, kb = r / nblk, nb = r % nblk;
            transpose_item(P.in[which ? 17 : 6] + 32 * nb, DM, 0, (which ? W2O : W1O), DFF, 32 * nb, 64 * kb, 0, nullptr, scr, lane); continue; }
        r -= 2 * I_FO;
        if (r < I_QKV) { const int nblk = 3 * DATT / 32, kb = r / nblk, nb = r % nblk;
            transpose_item(P.in[8] + 32 * nb, DINP, 0, WIN, DM, 32 * nb, 64 * kb, 0, nullptr, scr, lane); continue; }
        r -= I_QKV;
        if (r < I_U) { const int nblk = 1024 / 32, kb = r / nblk, nb = r % nblk;
            transpose_item(P.in[8] + UOFF + 32 * nb, DINP, 0, WIN, DM, 3 * DATT + 32 * nb, 64 * kb, 0, nullptr, scr, lane); continue; }
        r -= I_U;
        if (r < I_WO) { const int nblk = DM / 32, kb = r / nblk, nb = r % nblk;
            transpose_item(P.in[14] + 32 * nb, DM, 0, WOUT, DM, 32 * nb, 64 * kb, 0, nullptr, scr, lane); continue; }
        r -= I_WO;
        { const int g = r / 32; r -= g * 32; const int kb = r / 8, nb = r % 8;
            transpose_item(P.in[12] + (size_t)g * 65536 + 32 * nb, 256, 0, WPOOL, 256, g * 256 + 32 * nb, 64 * kb, 0, P.in[13] + g * 256 + 32 * nb, scr, lane); }
    }
}

template <bool FLOGIT>
__device__ __forceinline__ void norm_mod_phase(const float* X, bf16* H, const float* gn, const float* shift, const float* scale, const LAS float* wf, const float* b_forget, float* LOGF, int gw, int NGW, int lane) {
    for (int m = gw; m < MTOK; m += NGW) {
        const int b = m / SEQ;
        const f32x4* xr = (const f32x4*)(X + (size_t)m * DM) + lane;
        f32x4 v[8]; float ss = 0.f;
#pragma unroll
        for (int j = 0; j < 8; ++j) { v[j] = xr[64 * j]; ss += (v[j].x * v[j].x + v[j].y * v[j].y) + (v[j].z * v[j].z + v[j].w * v[j].w); }
        const float rstd = 1.0f / sqrtf(wave_sum(ss) * (1.0f / DM) + EPS);
        const float* shp = shift + b * NMOD + 4 * lane; const float* scp = scale + b * NMOD + 4 * lane; const float* gp = gn + 4 * lane;
        unsigned long long* o8 = (unsigned long long*)(H + (size_t)m * DM) + lane;
#pragma unroll
        for (int j = 0; j < 8; ++j) { const f32x4 g4 = *(const f32x4*)(gp + 256 * j), s4 = *(const f32x4*)(scp + 256 * j), h4 = *(const f32x4*)(shp + 256 * j);
            v[j] = (v[j] * rstd) * g4 * (s4 + 1.0f) + h4;
            o8[64 * j] = (unsigned long long)pk2(v[j].x, v[j].y) | ((unsigned long long)pk2(v[j].z, v[j].w) << 32); }
        if constexpr (FLOGIT) {
            float acc[8];
#pragma unroll
            for (int h = 0; h < 8; ++h) { float a = 0.f;
#pragma unroll
                for (int j = 0; j < 8; ++j) { const f32x4 w = *(const LAS f32x4*)(wf + h * DM + 256 * j + 4 * lane); a += (v[j].x * w.x + v[j].y * w.y) + (v[j].z * w.z + v[j].w * w.w); }
                acc[h] = wave_sum(a); }
            float z = acc[0];
#pragma unroll
            for (int h = 1; h < 8; ++h) z = (lane == h) ? acc[h] : z;
            if (lane < 8) { z += b_forget[lane]; const float ls = fminf(z, 0.f) - log1pf(expf(-fabsf(z))); LOGF[(size_t)(b * NHEAD + lane) * SEQ + (m % SEQ)] = ls; }
        }
    }
}
__device__ __forceinline__ void final_norm_phase(float* X, const float* gn, int gw, int NGW, int lane) {
    for (int m = gw; m < MTOK; m += NGW) {
        f32x4* xr = (f32x4*)(X + (size_t)m * DM) + lane;
        f32x4 v[8]; float ss = 0.f;
#pragma unroll
        for (int j = 0; j < 8; ++j) { v[j] = xr[64 * j]; ss += (v[j].x * v[j].x + v[j].y * v[j].y) + (v[j].z * v[j].z + v[j].w * v[j].w); }
        const float rstd = 1.0f / sqrtf(wave_sum(ss) * (1.0f / DM) + EPS);
#pragma unroll
        for (int j = 0; j < 8; ++j) { const f32x4 g4 = *(const f32x4*)(gn + 4 * lane + 256 * j); xr[64 * j] = (v[j] * rstd) * g4; }
    }
}
__device__ __forceinline__ void cumsum_bh(const float* LOGF, float* F2, int bh, LAS double* sd, int tid, int wave, int lane) {
    const float* src = LOGF + (size_t)bh * SEQ + 8 * tid;
    const f32x4 a = *(const f32x4*)src, b = *(const f32x4*)(src + 4);
    double p[8]; p[0] = a.x; p[1] = p[0] + a.y; p[2] = p[1] + a.z; p[3] = p[2] + a.w; p[4] = p[3] + b.x; p[5] = p[4] + b.y; p[6] = p[5] + b.z; p[7] = p[6] + b.w;
    double t = p[7];
#pragma unroll
    for (int o = 1; o < 64; o <<= 1) { const double n = __shfl_up(t, o); if (lane >= o) t += n; }
    if (lane == 63) sd[wave] = t;
    __syncthreads();
    double off = t - p[7];
    for (int w = 0; w < wave; ++w) off += sd[w];
    const double L2E = 1.4426950408889634;
    f32x4 o0, o1;
    o0.x = (float)((off + p[0]) * L2E); o0.y = (float)((off + p[1]) * L2E); o0.z = (float)((off + p[2]) * L2E); o0.w = (float)((off + p[3]) * L2E);
    o1.x = (float)((off + p[4]) * L2E); o1.y = (float)((off + p[5]) * L2E); o1.z = (float)((off + p[6]) * L2E); o1.w = (float)((off + p[7]) * L2E);
    float* dst = F2 + (size_t)bh * SEQ + 8 * tid;
    *(f32x4*)dst = o0; *(f32x4*)(dst + 4) = o1;
    __syncthreads();
}

__device__ __forceinline__ void prep_phase(const Ptrs& P, LAS unsigned char* lds, int gw, int NGW, int wave, int lane, int gtid, int NGT) {
    const bf16* QRAW = (const bf16*)(P.ws + WS_QRAW); const bf16* VRAW = (const bf16*)(P.ws + WS_VRAW); const bf16* U = (const bf16*)(P.ws + WS_U);
    bf16* QN = (bf16*)(P.ws + WS_QN); bf16* VT = (bf16*)(P.ws + WS_VT); bf16* POOLED = (bf16*)(P.ws + WS_POOLED);
    {
        const int l16 = lane & 15, g4 = lane >> 4;
        const float qs = 0.08838834764831845f * 1.4426950408889634f;
        for (int it = gw; it < MTOK * 16 / 4; it += NGW) {
            const int grp = it * 4 + g4, m = grp >> 4, hh = grp & 15, isk = hh >> 3, h = hh & 7;
            const u32x4 w = *(const u32x4*)(QRAW + (size_t)isk * ((WS_KRAW - WS_QRAW) / 2) + (size_t)m * DATT + h * HDIM + 8 * l16);
            float x[8] = {bf_lo(w.x), bf_hi(w.x), bf_lo(w.y), bf_hi(w.y), bf_lo(w.z), bf_hi(w.z), bf_lo(w.w), bf_hi(w.w)};
            float ss = 0.f;
#pragma unroll
            for (int i = 0; i < 8; ++i) ss += x[i] * x[i];
            ss += __shfl_xor(ss, 1); ss += __shfl_xor(ss, 2); ss += __shfl_xor(ss, 4); ss += __shfl_xor(ss, 8);
            const float rs = (1.0f / sqrtf(ss * (1.0f / HDIM) + EPS)) * (isk ? 1.0f : qs);
            const float* gp = P.in[isk ? 11 : 10] + 8 * l16;
            const f32x4 ga = *(const f32x4*)gp, gb = *(const f32x4*)(gp + 4);
            u32x4 o; o.x = pk2(x[0] * rs * ga.x, x[1] * rs * ga.y); o.y = pk2(x[2] * rs * ga.z, x[3] * rs * ga.w); o.z = pk2(x[4] * rs * gb.x, x[5] * rs * gb.y); o.w = pk2(x[6] * rs * gb.z, x[7] * rs * gb.w);
            const int b = m / SEQ, s = m % SEQ;
            *(u32x4*)(QN + (size_t)isk * ((WS_KN - WS_QN) / 2) + ((size_t)(b * NHEAD + h) * SEQ + s) * HDIM + 8 * l16) = o;
        }
    }
    {
        LAS unsigned short* scr = (LAS unsigned short*)(lds + wave * 8448);
        for (int it = gw; it < (MTOK / 32) * NHEAD; it += NGW) {
            const int mb = it / NHEAD, h = it % NHEAD, m0 = mb * 32, b = m0 / SEQ, s0 = m0 % SEQ;
#pragma unroll
            for (int i = 0; i < 8; ++i) { const int r = (lane >> 4) + 4 * i, c = (lane & 15) * 8;
                const u32x4 w = *(const u32x4*)(VRAW + (size_t)(m0 + r) * DATT + h * HDIM + c);
                LAS unsigned* d = (LAS unsigned*)(scr + r * 130 + c); d[0] = w.x; d[1] = w.y; d[2] = w.z; d[3] = w.w; }
            asm volatile("s_waitcnt lgkmcnt(0)" ::: "memory");
#pragma unroll
            for (int i2 = 0; i2 < 2; ++i2) { const int d = lane + 64 * i2; unsigned o[16];
#pragma unroll
                for (int s = 0; s < 16; ++s) o[s] = (unsigned)scr[(2 * s) * 130 + d] | ((unsigned)scr[(2 * s + 1) * 130 + d] << 16);
                bf16* dst = VT + ((size_t)(b * NHEAD + h) * HDIM + d) * SEQ + s0;
#pragma unroll
                for (int q = 0; q < 4; ++q) { u32x4 w = {o[4 * q], o[4 * q + 1], o[4 * q + 2], o[4 * q + 3]}; *(u32x4*)(dst + 8 * q) = w; } }
            asm volatile("s_waitcnt lgkmcnt(0)" ::: "memory");
        }
    }
    for (int it = gtid; it < MTOK * 128; it += NGT) {
        const int m = it >> 7, cc = (it & 127) * 8, s = m % SEQ, w = 2 << (cc >> 8), cnt = (s + 1 < w) ? s + 1 : w;
        float acc[8] = {0.f, 0.f, 0.f, 0.f, 0.f, 0.f, 0.f, 0.f}, self[8];
        for (int i = 0; i < cnt; ++i) { const u32x4 u = *(const u32x4*)(U + (size_t)(m - i) * 1024 + cc);
            const float x[8] = {bf_lo(u.x), bf_hi(u.x), bf_lo(u.y), bf_hi(u.y), bf_lo(u.z), bf_hi(u.z), bf_lo(u.w), bf_hi(u.w)};
#pragma unroll
            for (int e = 0; e < 8; ++e) { acc[e] += x[e]; if (i == 0) self[e] = x[e]; } }
        const float inv = 1.0f / (float)cnt;
        u32x4 o; o.x = pk2(acc[0] * inv - self[0], acc[1] * inv - self[1]); o.y = pk2(acc[2] * inv - self[2], acc[3] * inv - self[3]);
        o.z = pk2(acc[4] * inv - self[4], acc[5] * inv - self[5]); o.w = pk2(acc[6] * inv - self[6], acc[7] * inv - self[7]);
        *(u32x4*)(POOLED + (size_t)m * 1024 + cc) = o;
    }
}

constexpr int AT_KB = 64 * 272, AT_VB = 128 * 144;
__device__ __forceinline__ void attn_unit(LAS unsigned char* lds, const bf16* QN, const bf16* KN, const bf16* VT, const float* F2, bf16* A2, int bh, int qb, int tid, int wave, int lane) {
    const int fr = lane & 15, fq = lane >> 4;
    const int q0 = qb * 128, r0 = q0 + 16 * wave, ntiles = 2 * (qb + 1);
    LAS unsigned char* Kb = lds; LAS unsigned char* Vb = lds + 2 * AT_KB; LAS float* Bb = (LAS float*)(lds + 2 * AT_KB + 2 * AT_VB);
    const bf16* Kg = KN + (size_t)bh * SEQ * HDIM; const bf16* Vg = VT + (size_t)bh * HDIM * SEQ; const float* Fg = F2 + (size_t)bh * SEQ;
    bf16x8 qf[4];
#pragma unroll
    for (int kk = 0; kk < 4; ++kk) qf[kk] = *(const bf16x8*)(QN + ((size_t)bh * SEQ + r0 + fr) * HDIM + 32 * kk + 8 * fq);
    f32x4 o[8];
#pragma unroll
    for (int db = 0; db < 8; ++db) o[db] = (f32x4){0.f, 0.f, 0.f, 0.f};
    float mrun = -1e30f, lrun = 0.f;
    const int kr0 = tid >> 4, kc = tid & 15, vd0 = tid >> 3, vc = tid & 7;
    u32x4 sk0, sk1, sv0, sv1; float sb = 0.f;
#define AT_LOAD(j) do { const bf16* kp = Kg + (size_t)(64 * (j) + kr0) * HDIM + kc * 8; sk0 = *(const u32x4*)kp; sk1 = *(const u32x4*)(kp + 32 * HDIM); \
        const bf16* vp = Vg + (size_t)vd0 * SEQ + 64 * (j) + vc * 8; sv0 = *(const u32x4*)vp; sv1 = *(const u32x4*)(vp + (size_t)64 * SEQ); \
        if (tid < 64) sb = -Fg[64 * (j) + tid]; } while (0)
#define AT_STORE(buf) do { LAS unsigned char* kd = Kb + (buf) * AT_KB + kr0 * 272 + kc * 16; *(LAS u32x4*)kd = sk0; *(LAS u32x4*)(kd + 32 * 272) = sk1; \
        LAS unsigned char* vd = Vb + (buf) * AT_VB + vd0 * 144 + vc * 16; *(LAS u32x4*)vd = sv0; *(LAS u32x4*)(vd + 64 * 144) = sv1; \
        if (tid < 64) Bb[(buf) * 64 + tid] = sb; } while (0)
    AT_LOAD(0); AT_STORE(0); __syncthreads();
    for (int j = 0; j < ntiles; ++j) {
        const int buf = j & 1, kb = 64 * j;
        if (j + 1 < ntiles) AT_LOAD(j + 1);
        if (kb <= r0 + 15) {
            const LAS unsigned char* K_ = Kb + buf * AT_KB + fr * 272 + 16 * fq; const LAS unsigned char* V_ = Vb + buf * AT_VB + fr * 144 + 8 * fq; const LAS float* B_ = Bb + buf * 64 + 4 * fq;
            f32x4 s[4];
#pragma unroll
            for (int blk = 0; blk < 4; ++blk) s[blk] = *(const LAS f32x4*)(B_ + 16 * blk);
#pragma unroll
            for (int kk = 0; kk < 4; ++kk)
#pragma unroll
                for (int blk = 0; blk < 4; ++blk) { const bf16x8 a = *(const LAS bf16x8*)(K_ + blk * 16 * 272 + 64 * kk); s[blk] = __builtin_amdgcn_mfma_f32_16x16x32_bf16(a, qf[kk], s[blk], 0, 0, 0); }
            if (kb + 63 > r0) { const int qrow = r0 + fr;
#pragma unroll
                for (int blk = 0; blk < 4; ++blk)
#pragma unroll
                    for (int jj = 0; jj < 4; ++jj) if (kb + 16 * blk + 4 * fq + jj > qrow) s[blk][jj] = -__builtin_inff(); }
            float mx = s[0][0];
#pragma unroll
            for (int blk = 0; blk < 4; ++blk)
#pragma unroll
                for (int jj = 0; jj < 4; ++jj) mx = fmaxf(mx, s[blk][jj]);
            mx = fmaxf(mx, __shfl_xor(mx, 16)); mx = fmaxf(mx, __shfl_xor(mx, 32));
            const float mnew = fmaxf(mrun, mx), alpha = __builtin_amdgcn_exp2f(mrun - mnew); mrun = mnew;
            float ps = 0.f;
#pragma unroll
            for (int blk = 0; blk < 4; ++blk)
#pragma unroll
                for (int jj = 0; jj < 4; ++jj) { const float p = __builtin_amdgcn_exp2f(s[blk][jj] - mnew); s[blk][jj] = p; ps += p; }
            lrun = lrun * alpha + ps;
#pragma unroll
            for (int db = 0; db < 8; ++db) o[db] *= alpha;
            bf16x8 pb[2];
#pragma unroll
            for (int k2 = 0; k2 < 2; ++k2) { u32x4 w; w.x = pk2(s[2 * k2][0], s[2 * k2][1]); w.y = pk2(s[2 * k2][2], s[2 * k2][3]); w.z = pk2(s[2 * k2 + 1][0], s[2 * k2 + 1][1]); w.w = pk2(s[2 * k2 + 1][2], s[2 * k2 + 1][3]);
                pb[k2] = __builtin_bit_cast(bf16x8, w); }
#pragma unroll
            for (int db = 0; db < 8; ++db)
#pragma unroll
                for (int k2 = 0; k2 < 2; ++k2) { const u32x2 lo = *(const LAS u32x2*)(V_ + db * 16 * 144 + 64 * k2), hi = *(const LAS u32x2*)(V_ + db * 16 * 144 + 64 * k2 + 32);
                    const u32x4 w = {lo.x, lo.y, hi.x, hi.y}; o[db] = __builtin_amdgcn_mfma_f32_16x16x32_bf16(__builtin_bit_cast(bf16x8, w), pb[k2], o[db], 0, 0, 0); }
        }
        if (j + 1 < ntiles) AT_STORE(buf ^ 1);
        __syncthreads();
    }
#undef AT_LOAD
#undef AT_STORE
    float lt = lrun + __shfl_xor(lrun, 16); lt += __shfl_xor(lt, 32);
    const float inv = 1.0f / lt;
    const int b = bh >> 3, h = bh & 7;
    bf16* op = A2 + (size_t)(b * SEQ + r0 + fr) * DM + h * HDIM + 4 * fq;
#pragma unroll
    for (int db = 0; db < 8; ++db) { const f32x4 v = o[db] * inv; u32x2 w; w.x = pk2(v[0], v[1]); w.y = pk2(v[2], v[3]); *(u32x2*)(op + 16 * db) = w; }
}

__global__ void __launch_bounds__(NTHREADS, 2) mk_fwd(Ptrs P) {
    extern __shared__ __attribute__((aligned(16))) unsigned char lds_raw[];
    LAS unsigned char* lds = (LAS unsigned char*)lds_raw;
    cg::grid_group grid = cg::this_grid();
    const int tid = threadIdx.x, lane = tid & 63, wave = __builtin_amdgcn_readfirstlane(tid >> 6);
    const int G = gridDim.x, blk = blockIdx.x;
    const int gw = blk * NWAVES + wave, NGW = G * NWAVES, gtid = blk * NTHREADS + tid, NGT = G * NTHREADS;
    unsigned char* ws = P.ws;
    float* MOD = (float*)(ws + WS_MOD); float* LOGF = (float*)(ws + WS_LOGF); float* F2 = (float*)(ws + WS_F2);
    bf16* H = (bf16*)(ws + WS_H); bf16* ACT = (bf16*)(ws + WS_ACT); bf16* A2 = (bf16*)(ws + WS_A2);
    const float* x = P.in[0]; float* out = P.out;
#define GRID_SYNC() grid.sync()

    p0_mod(P.in[1], P.in[2], P.in[3], MOD, (LAS float*)lds, G, blk, tid);
    p0_convert(P, (LAS float*)(lds + wave * 16384), gw, NGW, lane);
    GRID_SYNC();
    norm_mod_phase<false>(x, H, P.in[4], MOD + 0 * DM, MOD + 1 * DM, nullptr, nullptr, nullptr, gw, NGW, lane);
    GRID_SYNC();
    { pg8::Gemm g{H, (const bf16*)(ws + WS_W1I), DM, DM, DM, 0}; pg8::StaticOrder S; S.init(MTOK, NFF2, G, blk); pg8::EpiSwiglu E{ACT, DFF};
      pg8::gemm_phase<pg8::EpiSwiglu, pg8::StaticOrder, true, true>(lds, g, S, E); }
    GRID_SYNC();
    { pg8::Gemm g{ACT, (const bf16*)(ws + WS_W1O), DFF, DFF, DFF, 0}; pg8::StaticOrder S; S.init(MTOK, DM, G, blk); pg8::EpiResid E{x, out, DM, MOD + 2 * DM, NMOD, SEQ, 0.5f};
      pg8::gemm_phase<pg8::EpiResid, pg8::StaticOrder, true, true>(lds, g, S, E); }
    GRID_SYNC();
    { LAS float* wf = (LAS float*)lds;
      for (int i = tid; i < DM * 8; i += NTHREADS) { const int k = i >> 3, h = i & 7; wf[h * DM + k] = P.in[8][(size_t)k * DINP + 3 * DATT + h]; }
      __syncthreads();
      norm_mod_phase<true>(out, H, P.in[7], MOD + 3 * DM, MOD + 4 * DM, wf, P.in[9], LOGF, gw, NGW, lane); }
    GRID_SYNC();
    if (blk < NBATCH * NHEAD) cumsum_bh(LOGF, F2, blk, (LAS double*)lds, tid, wave, lane);
    { pg8::Gemm g{H, (const bf16*)(ws + WS_WIN), DM, DM, DM, 0}; pg8::StaticOrder S; S.init(MTOK, 4 * DATT, G, blk); pg8::EpiBf16 E{(bf16*)(ws + WS_QRAW), DATT, DATT, (WS_KRAW - WS_QRAW) / 2};
      pg8::gemm_phase<pg8::EpiBf16, pg8::StaticOrder, true, true>(lds, g, S, E); }
    GRID_SYNC();
    prep_phase(P, lds, gw, NGW, wave, lane, gtid, NGT);
    GRID_SYNC();
    for (int it = blk; it < 256; it += G) { const int bh = it & 15, pi = it >> 4;
        attn_unit(lds, (const bf16*)(ws + WS_QN), (const bf16*)(ws + WS_KN), (const bf16*)(ws + WS_VT), F2, A2, bh, pi, tid, wave, lane);
        attn_unit(lds, (const bf16*)(ws + WS_QN), (const bf16*)(ws + WS_KN), (const bf16*)(ws + WS_VT), F2, A2, bh, 31 - pi, tid, wave, lane); }
    { pg8::Gemm g{(const bf16*)(ws + WS_POOLED), (const bf16*)(ws + WS_WPOOL), 1024, 256, 256, 512}; pg8::StaticOrder S; S.init(MTOK, 1024, G, blk); pg8::EpiBf16 E{A2 + 1024, DM, 0, 0};
      pg8::gemm_phase<pg8::EpiBf16, pg8::StaticOrder, true, true>(lds, g, S, E); }
    GRID_SYNC();
    { pg8::Gemm g{A2, (const bf16*)(ws + WS_WOUT), DM, DM, DM, 0}; pg8::StaticOrder S; S.init(MTOK, DM, G, blk); pg8::EpiResid E{out, out, DM, MOD + 5 * DM, NMOD, SEQ, 1.0f};
      pg8::gemm_phase<pg8::EpiResid, pg8::StaticOrder, true, true>(lds, g, S, E); }
    GRID_SYNC();
    norm_mod_phase<false>(out, H, P.in[15], MOD + 6 * DM, MOD + 7 * DM, nullptr, nullptr, nullptr, gw, NGW, lane);
    GRID_SYNC();
    { pg8::Gemm g{H, (const bf16*)(ws + WS_W2I), DM, DM, DM, 0}; pg8::StaticOrder S; S.init(MTOK, NFF2, G, blk); pg8::EpiSwiglu E{ACT, DFF};
      pg8::gemm_phase<pg8::EpiSwiglu, pg8::StaticOrder, true, true>(lds, g, S, E); }
    GRID_SYNC();
    { pg8::Gemm g{ACT, (const bf16*)(ws + WS_W2O), DFF, DFF, DFF, 0}; pg8::StaticOrder S; S.init(MTOK, DM, G, blk); pg8::EpiResid E{out, out, DM, MOD + 8 * DM, NMOD, SEQ, 0.5f};
      pg8::gemm_phase<pg8::EpiResid, pg8::StaticOrder, true, true>(lds, g, S, E); }
    GRID_SYNC();
    final_norm_phase(out, P.in[18], gw, NGW, lane);
}

extern "C" void kernel_launch(void* const* d_in, const int* in_sizes, int n_in, void* d_out, int out_size, void* d_ws, size_t ws_size, hipStream_t stream) {
    static int grid = 0;
    if (grid == 0) {
        if (n_in != 19 || out_size != MTOK * DM || ws_size < WS_END) { fprintf(stderr, "kernel_launch: unexpected shapes (n_in %d, out %d, ws %zu)\n", n_in, out_size, ws_size); grid = -1; return; }
        int dev = 0, cus = 0, per_cu = 0;
        hipGetDevice(&dev); hipDeviceGetAttribute(&cus, hipDeviceAttributeMultiprocessorCount, dev);
        if (hipFuncSetAttribute((const void*)mk_fwd, hipFuncAttributeMaxDynamicSharedMemorySize, LDS_BYTES) != hipSuccess) { fprintf(stderr, "kernel_launch: hipFuncSetAttribute failed\n"); grid = -1; return; }
        if (hipOccupancyMaxActiveBlocksPerMultiprocessor(&per_cu, (const void*)mk_fwd, NTHREADS, LDS_BYTES) != hipSuccess || per_cu < 1) { fprintf(stderr, "kernel_launch: occupancy query failed (%d)\n", per_cu); (void)hipGetLastError(); per_cu = 1; }
        grid = cus * (per_cu > 1 ? 1 : per_cu);
        if (grid < 1) grid = -1;
    }
    if (grid < 0) return;
    Ptrs p{};
    for (int i = 0; i < 19; ++i) p.in[i] = (const float*)d_in[i];
    p.out = (float*)d_out; p.ws = (unsigned char*)d_ws;
    void* args[] = {&p};
    hipError_t e = hipLaunchCooperativeKernel((const void*)mk_fwd, dim3(grid), dim3(NTHREADS), args, LDS_BYTES, stream);
    if (e != hipSuccess) fprintf(stderr, "cooperative launch failed: %s (grid %d)\n", hipGetErrorString(e), grid);
}
```

```cpp
#include <hip/hip_runtime.h>
#include <hip/hip_cooperative_groups.h>
#include <cstdio>
#include <cstdint>
namespace cg = cooperative_groups;

namespace pg8 {
#define PG8_LAS __attribute__((address_space(3)))
typedef unsigned short bf16_t;
typedef short bf16x8 __attribute__((ext_vector_type(8)));
typedef float f32x4 __attribute__((ext_vector_type(4)));
typedef unsigned u32x4 __attribute__((ext_vector_type(4)));
constexpr int BM = 256, BK = 64, HALF = 128, HTB = HALF * BK * 2  , STAGE_BYTES = 8 * HTB, NXCD = 8, WGM = 8;

__host__ __device__ __forceinline__ int lds_byte(int r, int c) { const int st = (r >> 4) * 2 + (c >> 5), rr = r & 15, cc = c & 31, ob = rr * 64 + cc * 2; return st * 1024 + (ob ^ (((ob >> 9) & 1) << 5)); }
__host__ __device__ __forceinline__ void stage_rc(int b, int& R, int& C) { const int st = b / 1024, sb = b % 1024, swz = sb ^ (((sb >> 9) & 1) << 5); R = (st >> 1) * 16 + swz / 64; C = (st & 1) * 32 + (swz % 64) / 2; }
__host__ __device__ __forceinline__ int perm32(int rho) { const int n = rho >> 4, i = rho & 15; return 8 * (i >> 2) + 4 * n + (i & 3); }

struct Unit { int pm, pn; };
struct Gemm { const bf16_t* A; const bf16_t* Bt; int lda, ldb, K; size_t a_pn_step; };

struct StaticOrder {
    int nM, nN, nwg, G, c;
    __host__ __device__ void init(int M, int N, int G_, int c_) { nM = M / BM; nN = N / BM; nwg = nM * nN; G = G_; c = c_; }
    __host__ __device__ bool next(int i, Unit& u) const {
        const long L = (long)i * G + c; if (L >= nwg) return false;
        int wgid = (int)L; { const int q = nwg / NXCD, r = nwg % NXCD, xcd = wgid % NXCD, off = wgid / NXCD; wgid = (xcd < r ? xcd * (q + 1) : r * (q + 1) + (xcd - r) * q) + off; }
        const int nig = WGM * nN, gid = wgid / nig, fm = gid * WGM, gsz = (nM - fm) < WGM ? (nM - fm) : WGM;
        u.pm = fm + ((wgid % nig) % gsz); u.pn = (wgid % nig) / gsz; return true;
    }
    __device__ __forceinline__ void a_ready(const Unit&) const {}
    __device__ __forceinline__ void done(const Unit&) const {}
};

__device__ __forceinline__ unsigned cvt_pk_bf16(float lo, float hi) { unsigned r; asm volatile("v_cvt_pk_bf16_f32 %0, %1, %2" : "=v"(r) : "v"(lo), "v"(hi)); return r; }

struct EpiBf16 {
    static constexpr bool PERM = true, AFTER_DRAIN = false;
    bf16_t* O; int ldc; int split_cols; size_t split_stride;
    __device__ __forceinline__ void operator()(const f32x4 (&acc)[2][2][4][2], const Unit& u, int wr, int wc, int fr, int fq) const {
        const int row0 = u.pm * BM + wr * 64 + fr; int colt = u.pn * BM; bf16_t* base = O;
        if (split_cols) { const int t = colt / split_cols; base += (size_t)t * split_stride; colt -= t * split_cols; }
        const int col0 = colt + wc * 32 + 8 * fq;
#pragma unroll
        for (int ai = 0; ai < 2; ++ai)
#pragma unroll
            for (int m = 0; m < 4; ++m) { bf16_t* rowp = base + (size_t)(row0 + ai * HALF + m * 16) * ldc + col0;
#pragma unroll
                for (int bj = 0; bj < 2; ++bj) { const f32x4 v0 = acc[ai][bj][m][0], v1 = acc[ai][bj][m][1];
                    u32x4 w; w.x = cvt_pk_bf16(v0[0], v0[1]); w.y = cvt_pk_bf16(v0[2], v0[3]); w.z = cvt_pk_bf16(v1[0], v1[1]); w.w = cvt_pk_bf16(v1[2], v1[3]);
                    *(u32x4*)(rowp + bj * HALF) = w; } }
    }
};
__device__ __forceinline__ float silu_f(float a) { return a * __builtin_amdgcn_rcpf(1.0f + __builtin_amdgcn_exp2f(-1.4426950408889634f * a)); }
struct EpiSwiglu {
    static constexpr bool PERM = true, AFTER_DRAIN = false;
    bf16_t* O; int ldc;
    __device__ __forceinline__ void operator()(const f32x4 (&acc)[2][2][4][2], const Unit& u, int wr, int wc, int fr, int fq) const {
        const int row0 = u.pm * BM + wr * 64 + fr; const int col0 = u.pn * HALF + wc * 32 + 8 * fq;
#pragma unroll
        for (int ai = 0; ai < 2; ++ai)
#pragma unroll
            for (int m = 0; m < 4; ++m) { bf16_t* rowp = O + (size_t)(row0 + ai * HALF + m * 16) * ldc + col0;
                const f32x4 a0 = acc[ai][0][m][0], a1 = acc[ai][0][m][1], b0 = acc[ai][1][m][0], b1 = acc[ai][1][m][1];
                u32x4 w;
                w.x = cvt_pk_bf16(silu_f(a0[0]) * b0[0], silu_f(a0[1]) * b0[1]); w.y = cvt_pk_bf16(silu_f(a0[2]) * b0[2], silu_f(a0[3]) * b0[3]);
                w.z = cvt_pk_bf16(silu_f(a1[0]) * b1[0], silu_f(a1[1]) * b1[1]); w.w = cvt_pk_bf16(silu_f(a1[2]) * b1[2], silu_f(a1[3]) * b1[3]);
                *(u32x4*)rowp = w; }
    }
};
struct EpiResid {
    static constexpr bool PERM = false, AFTER_DRAIN = false;
    const float* base; float* out; int ldc; const float* gate; int gate_bstride; int rows_per_batch; float coef;
    __device__ __forceinline__ void operator()(const f32x4 (&acc)[2][2][4][2], const Unit& u, int wr, int wc, int fr, int fq) const {
        const int col0 = u.pn * BM + wc * 32 + 4 * fq;
        const float* gp = gate + (size_t)((u.pm * BM) / rows_per_batch) * gate_bstride + col0;
        f32x4 gv[2][2];
#pragma unroll
        for (int bj = 0; bj < 2; ++bj)
#pragma unroll
            for (int n = 0; n < 2; ++n) gv[bj][n] = *(const f32x4*)(gp + bj * HALF + n * 16) * coef;
#pragma unroll
        for (int ai = 0; ai < 2; ++ai)
#pragma unroll
            for (int m = 0; m < 4; ++m) { const size_t off = (size_t)(u.pm * BM + ai * HALF + wr * 64 + m * 16 + fr) * ldc + col0;
#pragma unroll
                for (int bj = 0; bj < 2; ++bj)
#pragma unroll
                    for (int n = 0; n < 2; ++n) { const f32x4 bs = *(const f32x4*)(base + off + bj * HALF + n * 16);
                        *(f32x4*)(out + off + bj * HALF + n * 16) = bs + gv[bj][n] * acc[ai][bj][m][n]; }
                asm volatile("" ::: "memory"); }
    }
};

template <class Epi, class Sched, bool ALIGN_EPI = false, bool SP2 = false>
__device__ __forceinline__ void gemm_phase(PG8_LAS unsigned char* lds, const Gemm g, const Sched& S, const Epi& E) {
    const int tid = threadIdx.x, wid = __builtin_amdgcn_readfirstlane(tid >> 6), lane = tid & 63, wr = wid >> 2, wc = wid & 3, fr = lane & 15, fq = lane >> 4;
    const int K = g.K, nt = K / BK;
    unsigned voffA[2], voffB[2];
#pragma unroll
    for (int i = 0; i < 2; ++i) { int R, C; stage_rc(tid * 16 + i * 8192, R, C); const int Rb = Epi::PERM ? ((R & ~31) + perm32(R & 31)) : R;
        voffA[i] = (unsigned)(R * g.lda + C) * 2u; voffB[i] = (unsigned)(Rb * g.ldb + C) * 2u; }
    const size_t kstep = (size_t)(BK * 2);
    const size_t hstepA = (size_t)HALF * g.lda * 2, hstepB = (size_t)HALF * g.ldb * 2;
    const size_t tstepA = 2 * hstepA, tstepB = 2 * hstepB;
    const unsigned ldsw = (unsigned)wid * 1024u;
    const int aoff = lds_byte(wr * 64 + fr, fq * 8), boff = lds_byte(wc * 32 + fr, fq * 8);
#define PG8_SA(b, h) (((b) * 2 + (h)) * HTB)
#define PG8_SB(b, h) ((4 + (b) * 2 + (h)) * HTB)
#define PG8_STAGE(bufoff, gbase, voff) do { _Pragma("unroll") for (int _i = 0; _i < 2; ++_i) \
        __builtin_amdgcn_global_load_lds((const unsigned*)((const char*)(gbase) + (voff)[_i]), (PG8_LAS unsigned*)(lds + (bufoff) + ldsw + _i * 8192), 16, 0, 0); } while (0)
#define PG8_LDA(dst, b, h) do { _Pragma("unroll") for (int m = 0; m < 4; ++m) _Pragma("unroll") for (int k = 0; k < 2; ++k) dst[m][k] = *(const PG8_LAS bf16x8*)(lds + PG8_SA(b, h) + aoff + m * 2048 + k * 1024); } while (0)
#define PG8_LDB(dst, b, h) do { _Pragma("unroll") for (int n = 0; n < 2; ++n) _Pragma("unroll") for (int k = 0; k < 2; ++k) dst[n][k] = *(const PG8_LAS bf16x8*)(lds + PG8_SB(b, h) + boff + n * 2048 + k * 1024); } while (0)
#define PG8_MMA(ai, bj, At, Bt) do { __builtin_amdgcn_s_setprio(1); _Pragma("unroll") for (int m = 0; m < 4; ++m) _Pragma("unroll") for (int n = 0; n < 2; ++n) _Pragma("unroll") for (int k = 0; k < 2; ++k) \
        acc[ai][bj][m][n] = __builtin_amdgcn_mfma_f32_16x16x32_bf16(Bt[n][k], At[m][k], acc[ai][bj][m][n], 0, 0, 0); __builtin_amdgcn_s_setprio(0); } while (0)
#define PG8_WAIT_V(n) asm volatile("s_waitcnt vmcnt(" #n ")" ::: "memory")
#define PG8_WAIT_L(n) asm volatile("s_waitcnt lgkmcnt(" #n ")" ::: "memory")
#define PG8_BAR __builtin_amdgcn_s_barrier()
#define PG8_SCHED __builtin_amdgcn_sched_barrier(0)
    Unit cur, nxt; int ui = 0;
    if (!S.next(0, cur)) return;
    f32x4 acc[2][2][4][2];
#pragma unroll
    for (int a = 0; a < 2; ++a)
#pragma unroll
        for (int b = 0; b < 2; ++b)
#pragma unroll
            for (int m = 0; m < 4; ++m)
#pragma unroll
                for (int n = 0; n < 2; ++n) acc[a][b][m][n] = (f32x4){0.f, 0.f, 0.f, 0.f};
    bf16x8 At[4][2], B0[2][2], B1[2][2];
    const char* cA = (const char*)g.A + (size_t)cur.pm * tstepA + (size_t)cur.pn * g.a_pn_step; const char* cB = (const char*)g.Bt + (size_t)cur.pn * tstepB;
    S.a_ready(cur);
    if constexpr (SP2) {
        PG8_STAGE(PG8_SB(0, 0), cB, voffB); PG8_STAGE(PG8_SB(0, 1), cB + hstepB, voffB); PG8_STAGE(PG8_SA(0, 0), cA, voffA); PG8_STAGE(PG8_SA(0, 1), cA + hstepA, voffA);
        if (wr == 1) PG8_BAR;
        PG8_WAIT_V(2); PG8_BAR;
        PG8_STAGE(PG8_SB(1, 0), cB + kstep, voffB); PG8_STAGE(PG8_SA(1, 0), cA + kstep, voffA); PG8_STAGE(PG8_SB(1, 1), cB + hstepB + kstep, voffB);
        PG8_WAIT_V(6); PG8_BAR;
    } else {
        PG8_STAGE(PG8_SB(0, 0), cB, voffB); PG8_STAGE(PG8_SA(0, 0), cA, voffA); PG8_STAGE(PG8_SB(0, 1), cB + hstepB, voffB); PG8_STAGE(PG8_SA(0, 1), cA + hstepA, voffA);
        if (wr == 1) PG8_BAR;
        PG8_WAIT_V(4); PG8_BAR;
        PG8_STAGE(PG8_SB(1, 0), cB + kstep, voffB); PG8_STAGE(PG8_SA(1, 0), cA + kstep, voffA); PG8_STAGE(PG8_SB(1, 1), cB + hstepB + kstep, voffB);
        PG8_WAIT_V(6); PG8_BAR;
    }
    for (;;) {
        const bool has_next = S.next(ui + 1, nxt);
        const char* nA = has_next ? (const char*)g.A + (size_t)nxt.pm * tstepA + (size_t)nxt.pn * g.a_pn_step : cA; const char* nB = has_next ? (const char*)g.Bt + (size_t)nxt.pn * tstepB : cB;
        for (int t = 0; t < nt; t += 2) {
            const bool last = (t == nt - 2);
            const char* a1 = cA + (size_t)(t + 1) * kstep;
            const char* a2 = last ? nA : cA + (size_t)(t + 2) * kstep; const char* b2 = last ? nB : cB + (size_t)(t + 2) * kstep;
            const char* a3 = a2 + kstep; const char* b3 = b2 + kstep;
            if (last && has_next) S.a_ready(nxt);
            if constexpr (SP2) {
            PG8_LDB(B0, 0, 0); PG8_LDB(B1, 0, 1); PG8_SCHED; PG8_LDA(At, 0, 0); PG8_STAGE(PG8_SA(1, 1), a1 + hstepA, voffA);
            PG8_WAIT_V(8); PG8_WAIT_L(0); PG8_BAR; PG8_MMA(0, 0, At, B0); PG8_MMA(0, 1, At, B1); PG8_BAR; PG8_SCHED;
            PG8_LDA(At, 0, 1); PG8_STAGE(PG8_SB(0, 0), b2, voffB); PG8_STAGE(PG8_SB(0, 1), b2 + hstepB, voffB); PG8_STAGE(PG8_SA(0, 0), a2, voffA);
            PG8_WAIT_V(8); PG8_WAIT_L(0); PG8_BAR; PG8_MMA(1, 0, At, B0); PG8_MMA(1, 1, At, B1); PG8_BAR; PG8_SCHED;
            PG8_LDB(B0, 1, 0); PG8_LDB(B1, 1, 1); PG8_SCHED; PG8_LDA(At, 1, 0); PG8_STAGE(PG8_SA(0, 1), a2 + hstepA, voffA);
            PG8_WAIT_V(8); PG8_WAIT_L(0); PG8_BAR; PG8_MMA(0, 0, At, B0); PG8_MMA(0, 1, At, B1); PG8_BAR; PG8_SCHED;
            PG8_LDA(At, 1, 1); PG8_STAGE(PG8_SB(1, 0), b3, voffB); PG8_STAGE(PG8_SB(1, 1), b3 + hstepB, voffB); PG8_STAGE(PG8_SA(1, 0), a3, voffA);
            PG8_WAIT_V(8); PG8_WAIT_L(0); PG8_BAR; PG8_MMA(1, 0, At, B0); PG8_MMA(1, 1, At, B1); PG8_BAR; PG8_SCHED;
            } else {
            PG8_LDB(B0, 0, 0); PG8_SCHED; PG8_LDA(At, 0, 0); PG8_STAGE(PG8_SA(1, 1), a1 + hstepA, voffA);
            PG8_WAIT_L(8); PG8_BAR; PG8_WAIT_L(0); PG8_MMA(0, 0, At, B0); PG8_BAR; PG8_SCHED;
            PG8_LDB(B1, 0, 1); PG8_STAGE(PG8_SB(0, 0), b2, voffB);
            PG8_BAR; PG8_WAIT_L(0); PG8_MMA(0, 1, At, B1); PG8_BAR;
            PG8_LDA(At, 0, 1); PG8_STAGE(PG8_SA(0, 0), a2, voffA);
            PG8_BAR; PG8_WAIT_L(0); PG8_MMA(1, 0, At, B0); PG8_BAR; PG8_SCHED;
            PG8_STAGE(PG8_SB(0, 1), b2 + hstepB, voffB);
            PG8_WAIT_V(6); PG8_BAR; PG8_MMA(1, 1, At, B1); PG8_BAR;
            PG8_LDB(B0, 1, 0); PG8_SCHED; PG8_LDA(At, 1, 0); PG8_STAGE(PG8_SA(0, 1), a2 + hstepA, voffA);
            PG8_WAIT_L(8); PG8_BAR; PG8_WAIT_L(0); PG8_MMA(0, 0, At, B0); PG8_BAR; PG8_SCHED;
            PG8_LDB(B1, 1, 1); PG8_STAGE(PG8_SB(1, 0), b3, voffB);
            PG8_BAR; PG8_WAIT_L(0); PG8_MMA(0, 1, At, B1); PG8_BAR;
            PG8_LDA(At, 1, 1); PG8_STAGE(PG8_SA(1, 0), a3, voffA);
            PG8_BAR; PG8_WAIT_L(0); PG8_MMA(1, 0, At, B0); PG8_BAR; PG8_SCHED;
            PG8_STAGE(PG8_SB(1, 1), b3 + hstepB, voffB);
            PG8_WAIT_V(6); PG8_BAR; PG8_MMA(1, 1, At, B1); PG8_BAR;
            }
        }
        if constexpr (ALIGN_EPI) { if (wr == 0) PG8_BAR; }
        if constexpr (!Epi::AFTER_DRAIN) { E(acc, cur, wr, wc, fr, fq); S.done(cur); }
        if (!has_next) break;
#pragma unroll
        for (int a = 0; a < 2; ++a)
#pragma unroll
            for (int b = 0; b < 2; ++b)
#pragma unroll
                for (int m = 0; m < 4; ++m)
#pragma unroll
                    for (int n = 0; n < 2; ++n) acc[a][b][m][n] = (f32x4){0.f, 0.f, 0.f, 0.f};
        cur = nxt; cA = nA; cB = nB; ++ui;
        if constexpr (ALIGN_EPI) { if (wr == 1) PG8_BAR; }
    }
    PG8_WAIT_V(0);
    if constexpr (!ALIGN_EPI) { if (wr == 0) PG8_BAR; }
    PG8_BAR;
    if constexpr (Epi::AFTER_DRAIN) { E.fused(acc, cur, wr, wc, fr, fq, lds, wid, lane); S.done(cur); }
#undef PG8_SA
#undef PG8_SB
#undef PG8_STAGE
#undef PG8_LDA
#undef PG8_LDB
#undef PG8_MMA
#undef PG8_WAIT_V
#undef PG8_WAIT_L
#undef PG8_BAR
#undef PG8_SCHED
}
}

constexpr int DM = 2048, NBATCH = 2, SEQ = 4096, MTOK = NBATCH * SEQ, DFF = 5504, NFF2 = 2 * DFF, DATT = 1024, NHEAD = 8, HDIM = 128;
constexpr int NMOD = 9 * DM, DINP = 3 * DATT + NHEAD + 1024, UOFF = 3 * DATT + NHEAD;
constexpr float EPS = 1e-6f;
constexpr int NTHREADS = 512, NWAVES = 8;
constexpr int LDS_BYTES = 147456;

constexpr size_t MiB = 1u << 20;
constexpr size_t WS_CTL = 0, WS_MOD = 1 * MiB, WS_LOGF = 2 * MiB, WS_F2 = 2 * MiB + 512 * 1024;
constexpr size_t WS_W1I = 4 * MiB, WS_W1O = 48 * MiB, WS_W2I = 72 * MiB, WS_W2O = 116 * MiB, WS_WIN = 140 * MiB, WS_WOUT = 156 * MiB, WS_WPOOL = 164 * MiB;
constexpr size_t WS_H = 168 * MiB, WS_ACT = 200 * MiB, WS_QRAW = 288 * MiB, WS_KRAW = 304 * MiB, WS_VRAW = 320 * MiB, WS_U = 336 * MiB;
constexpr size_t WS_QN = 352 * MiB, WS_KN = 368 * MiB, WS_VT = 384 * MiB, WS_POOLED = 400 * MiB, WS_A2 = 416 * MiB, WS_END = 448 * MiB;

#define LAS __attribute__((address_space(3)))
typedef unsigned short bf16;
typedef float f32x4 __attribute__((ext_vector_type(4)));
typedef short bf16x8 __attribute__((ext_vector_type(8)));
typedef unsigned u32x4 __attribute__((ext_vector_type(4)));
typedef unsigned u32x2 __attribute__((ext_vector_type(2)));

__device__ __forceinline__ unsigned f2bf(float f) { unsigned u = __builtin_bit_cast(unsigned, f); return (u + 0x7fffu + ((u >> 16) & 1u)) >> 16; }
__device__ __forceinline__ unsigned pk2(float lo, float hi) { return pg8::cvt_pk_bf16(lo, hi); }
__device__ __forceinline__ float bf_lo(unsigned w) { return __builtin_bit_cast(float, w << 16); }
__device__ __forceinline__ float bf_hi(unsigned w) { return __builtin_bit_cast(float, w & 0xffff0000u); }
__device__ __forceinline__ float wave_sum(float v) {
#pragma unroll
    for (int o = 1; o < 64; o <<= 1) v += __shfl_xor(v, o);
    return v;
}

__device__ __forceinline__ void p0_mod(const float* c, const float* w_ada, const float* b_ada, float* mod, LAS float* lds, int G, int blk, int tid) {
    LAS float* ca = lds; LAS float* red = lds + 4096;
    for (int i = tid; i < 2 * DM; i += NTHREADS) { const float v = c[i]; ca[i] = v / (1.f + __expf(-v)); }
    __syncthreads();
    const int cgp = tid % 18, rg = tid / 18;
    for (int ch = blk; ch < NMOD / 72; ch += G) {
        f32x4 a0 = {0.f, 0.f, 0.f, 0.f}, a1 = {0.f, 0.f, 0.f, 0.f};
        if (tid < 504) {
            const float* wp = w_ada + (size_t)72 * ch + 4 * cgp;
#pragma unroll 4
            for (int k = rg; k < DM; k += 28) { const f32x4 w = *(const f32x4*)(wp + (size_t)k * NMOD); const float s0 = ca[k], s1 = ca[DM + k]; a0 += w * s0; a1 += w * s1; }
            LAS float* r = red + (rg * 18 + cgp) * 8;
            *(LAS f32x4*)r = a0; *(LAS f32x4*)(r + 4) = a1;
        }
        __syncthreads();
        if (tid < 144) { const int b = tid / 72, n = tid % 72; float s = 0.f;
            for (int r = 0; r < 28; ++r) s += red[(r * 18 + (n >> 2)) * 8 + b * 4 + (n & 3)];
            mod[b * NMOD + 72 * ch + n] = s + b_ada[72 * ch + n]; }
        __syncthreads();
    }
}
__device__ __forceinline__ void transpose_item(const float* W, int ldw, int coff, bf16* WT, int ldt, int r0, int k0, int n0, const float* nscale, LAS float* scr, int lane) {
#pragma unroll 8
    for (int i = 0; i < 32; ++i) { const int kk = 2 * i + (lane >> 5); scr[kk * 33 + (lane & 31)] = W[(size_t)(k0 + kk) * ldw + coff + n0 + (lane & 31)]; }
    asm volatile("s_waitcnt lgkmcnt(0)" ::: "memory");
    const int c = lane & 7;
#pragma unroll
    for (int j = 0; j < 4; ++j) { const int n = (lane >> 3) + 8 * j; const LAS float* s = scr + (8 * c) * 33 + n;
        const float sc = nscale ? nscale[n0 + n] : 1.f;
        u32x4 o; o.x = pk2(s[0 * 33] * sc, s[1 * 33] * sc); o.y = pk2(s[2 * 33] * sc, s[3 * 33] * sc); o.z = pk2(s[4 * 33] * sc, s[5 * 33] * sc); o.w = pk2(s[6 * 33] * sc, s[7 * 33] * sc);
        *(u32x4*)(WT + (size_t)(r0 + n) * ldt + k0 + 8 * c) = o; }
    asm volatile("s_waitcnt lgkmcnt(0)" ::: "memory");
}
struct Ptrs {
    const float* in[19]; float* out; unsigned char* ws;
};
__device__ __forceinline__ void p0_convert(const Ptrs& P, LAS float* scr, int gw, int NGW, int lane) {
    bf16* W1I = (bf16*)(P.ws + WS_W1I); bf16* W1O = (bf16*)(P.ws + WS_W1O); bf16* W2I = (bf16*)(P.ws + WS_W2I); bf16* W2O = (bf16*)(P.ws + WS_W2O);
    bf16* WIN = (bf16*)(P.ws + WS_WIN); bf16* WOUT = (bf16*)(P.ws + WS_WOUT); bf16* WPOOL = (bf16*)(P.ws + WS_WPOOL);
    constexpr int I_FI = (DM / 64) * (NFF2 / 32), I_FO = (DFF / 64) * (DM / 32), I_QKV = (DM / 64) * (3 * DATT / 32), I_U = (DM / 64) * (1024 / 32), I_WO = (DM / 64) * (DM / 32), I_PW = 4 * (256 / 64) * (256 / 32);
    constexpr int NITEMS = 2 * I_FI + 2 * I_FO + I_QKV + I_U + I_WO + I_PW;
    for (int it = gw; it < NITEMS; it += NGW) {
        int r = it;
        if (r < 2 * I_FI) { const int which = r / I_FI; r -= which * I_FI; const int nblk = NFF2 / 32, kb = r / nblk, nb = r % nblk, n0 = 32 * nb;
            const int j = n0 < DFF ? n0 : n0 - DFF; const int r0 = 256 * (j / 128) + (n0 < DFF ? 0 : 128) + (j % 128);
            transpose_item(P.in[which ? 16 : 5] + n0, NFF2, 0, which ? W2I : W1I, DM, r0, 64 * kb, 0, nullptr, scr, lane);
            continue; }
        r -= 2 * I_FI;
        if (r < 2 * I_FO) { const int which = r / I_FO; r -= which * I_FO; const int nblk = DM / 32, kb = r / nblk, nb = r % nblk;
            transpose_item(P.in[which ? 17 : 6] + 32 * nb, DM, 0, (which ? W2O : W1O), DFF, 32 * nb, 64 * kb, 0, nullptr, scr, lane); continue; }
        r -= 2 * I_FO;
        if (r < I_QKV) { const int nblk = 3 * DATT / 32, kb = r / nblk, nb = r % nblk;
            transpose_item(P.in[8] + 32 * nb, DINP, 0, WIN, DM, 32 * nb, 64 * kb, 0, nullptr, scr, lane); continue; }
        r -= I_QKV;
        if (r < I_U) { const int nblk = 1024 / 32, kb = r / nblk, nb = r % nblk;
            transpose_item(P.in[8] + UOFF + 32 * nb, DINP, 0, WIN, DM, 3 * DATT + 32 * nb, 64 * kb, 0, nullptr, scr, lane); continue; }
        r -= I_U;
        if (r < I_WO) { const int nblk = DM / 32, kb = r / nblk, nb = r % nblk;
            transpose_item(P.in[14] + 32 * nb, DM, 0, WOUT, DM, 32 * nb, 64 * kb, 0, nullptr, scr, lane); continue; }
        r -= I_WO;
        { const int g = r / 32; r -= g * 32; const int kb = r / 8, nb = r % 8;
            transpose_item(P.in[12] + (size_t)g * 65536 + 32 * nb, 256, 0, WPOOL, 256, g * 256 + 32 * nb, 64 * kb, 0, P.in[13] + g * 256 + 32 * nb, scr, lane); }
    }
}

template <bool FLOGIT>
__device__ __forceinline__ void norm_mod_phase(const float* X, bf16* H, const float* gn, const float* shift, const float* scale, const LAS float* wf, const float* b_forget, float* LOGF, int gw, int NGW, int lane) {
    for (int m = gw; m < MTOK; m += NGW) {
        const int b = m / SEQ;
        const f32x4* xr = (const f32x4*)(X + (size_t)m * DM) + lane;
        f32x4 v[8]; float ss = 0.f;
#pragma unroll
        for (int j = 0; j < 8; ++j) { v[j] = xr[64 * j]; ss += (v[j].x * v[j].x + v[j].y * v[j].y) + (v[j].z * v[j].z + v[j].w * v[j].w); }
        const float rstd = 1.0f / sqrtf(wave_sum(ss) * (1.0f / DM) + EPS);
        const float* shp = shift + b * NMOD + 4 * lane; const float* scp = scale + b * NMOD + 4 * lane; const float* gp = gn + 4 * lane;
        unsigned long long* o8 = (unsigned long long*)(H + (size_t)m * DM) + lane;
#pragma unroll
        for (int j = 0; j < 8; ++j) { const f32x4 g4 = *(const f32x4*)(gp + 256 * j), s4 = *(const f32x4*)(scp + 256 * j), h4 = *(const f32x4*)(shp + 256 * j);
            v[j] = (v[j] * rstd) * g4 * (s4 + 1.0f) + h4;
            o8[64 * j] = (unsigned long long)pk2(v[j].x, v[j].y) | ((unsigned long long)pk2(v[j].z, v[j].w) << 32); }
        if constexpr (FLOGIT) {
            float acc[8];
#pragma unroll
            for (int h = 0; h < 8; ++h) { float a = 0.f;
#pragma unroll
                for (int j = 0; j < 8; ++j) { const f32x4 w = *(const LAS f32x4*)(wf + h * DM + 256 * j + 4 * lane); a += (v[j].x * w.x + v[j].y * w.y) + (v[j].z * w.z + v[j].w * w.w); }
                acc[h] = wave_sum(a); }
            float z = acc[0];
#pragma unroll
            for (int h = 1; h < 8; ++h) z = (lane == h) ? acc[h] : z;
            if (lane < 8) { z += b_forget[lane]; const float ls = fminf(z, 0.f) - log1pf(expf(-fabsf(z))); LOGF[(size_t)(b * NHEAD + lane) * SEQ + (m % SEQ)] = ls; }
        }
    }
}
__device__ __forceinline__ void final_norm_phase(float* X, const float* gn, int gw, int NGW, int lane) {
    for (int m = gw; m < MTOK; m += NGW) {
        f32x4* xr = (f32x4*)(X + (size_t)m * DM) + lane;
        f32x4 v[8]; float ss = 0.f;
#pragma unroll
        for (int j = 0; j < 8; ++j) { v[j] = xr[64 * j]; ss += (v[j].x * v[j].x + v[j].y * v[j].y) + (v[j].z * v[j].z + v[j].w * v[j].w); }
        const float rstd = 1.0f / sqrtf(wave_sum(ss) * (1.0f / DM) + EPS);
#pragma unroll
        for (int j = 0; j < 8; ++j) { const f32x4 g4 = *(const f32x4*)(gn + 4 * lane + 256 * j); xr[64 * j] = (v[j] * rstd) * g4; }
    }
}
__device__ __forceinline__ void cumsum_bh(const float* LOGF, float* F2, int bh, LAS double* sd, int tid, int wave, int lane) {
    const float* src = LOGF + (size_t)bh * SEQ + 8 * tid;
    const f32x4 a = *(const f32x4*)src, b = *(const f32x4*)(src + 4);
    double p[8]; p[0] = a.x; p[1] = p[0] + a.y; p[2] = p[1] + a.z; p[3] = p[2] + a.w; p[4] = p[3] + b.x; p[5] = p[4] + b.y; p[6] = p[5] + b.z; p[7] = p[6] + b.w;
    double t = p[7];
#pragma unroll
    for (int o = 1; o < 64; o <<= 1) { const double n = __shfl_up(t, o); if (lane >= o) t += n; }
    if (lane == 63) sd[wave] = t;
    __syncthreads();
    double off = t - p[7];
    for (int w = 0; w < wave; ++w) off += sd[w];
    const double L2E = 1.4426950408889634;
    f32x4 o0, o1;
    o0.x = (float)((off + p[0]) * L2E); o0.y = (float)((off + p[1]) * L2E); o0.z = (float)((off + p[2]) * L2E); o0.w = (float)((off + p[3]) * L2E);
    o1.x = (float)((off + p[4]) * L2E); o1.y = (float)((off + p[5]) * L2E); o1.z = (float)((off + p[6]) * L2E); o1.w = (float)((off + p[7]) * L2E);
    float* dst = F2 + (size_t)bh * SEQ + 8 * tid;
    *(f32x4*)dst = o0; *(f32x4*)(dst + 4) = o1;
    __syncthreads();
}

__device__ __forceinline__ void prep_phase(const Ptrs& P, LAS unsigned char* lds, int gw, int NGW, int wave, int lane, int gtid, int NGT) {
    const bf16* QRAW = (const bf16*)(P.ws + WS_QRAW); const bf16* VRAW = (const bf16*)(P.ws + WS_VRAW); const bf16* U = (const bf16*)(P.ws + WS_U);
    bf16* QN = (bf16*)(P.ws + WS_QN); bf16* VT = (bf16*)(P.ws + WS_VT); bf16* POOLED = (bf16*)(P.ws + WS_POOLED);
    {
        const int l16 = lane & 15, g4 = lane >> 4;
        const float qs = 0.08838834764831845f * 1.4426950408889634f;
        for (int it = gw; it < MTOK * 16 / 4; it += NGW) {
            const int grp = it * 4 + g4, m = grp >> 4, hh = grp & 15, isk = hh >> 3, h = hh & 7;
            const u32x4 w = *(const u32x4*)(QRAW + (size_t)isk * ((WS_KRAW - WS_QRAW) / 2) + (size_t)m * DATT + h * HDIM + 8 * l16);
            float x[8] = {bf_lo(w.x), bf_hi(w.x), bf_lo(w.y), bf_hi(w.y), bf_lo(w.z), bf_hi(w.z), bf_lo(w.w), bf_hi(w.w)};
            float ss = 0.f;
#pragma unroll
            for (int i = 0; i < 8; ++i) ss += x[i] * x[i];
            ss += __shfl_xor(ss, 1); ss += __shfl_xor(ss, 2); ss += __shfl_xor(ss, 4); ss += __shfl_xor(ss, 8);
            const float rs = (1.0f / sqrtf(ss * (1.0f / HDIM) + EPS)) * (isk ? 1.0f : qs);
            const float* gp = P.in[isk ? 11 : 10] + 8 * l16;
            const f32x4 ga = *(const f32x4*)gp, gb = *(const f32x4*)(gp + 4);
            u32x4 o; o.x = pk2(x[0] * rs * ga.x, x[1] * rs * ga.y); o.y = pk2(x[2] * rs * ga.z, x[3] * rs * ga.w); o.z = pk2(x[4] * rs * gb.x, x[5] * rs * gb.y); o.w = pk2(x[6] * rs * gb.z, x[7] * rs * gb.w);
            const int b = m / SEQ, s = m % SEQ;
            *(u32x4*)(QN + (size_t)isk * ((WS_KN - WS_QN) / 2) + ((size_t)(b * NHEAD + h) * SEQ + s) * HDIM + 8 * l16) = o;
        }
    }
    {
        LAS unsigned short* scr = (LAS unsigned short*)(lds + wave * 8448);
        for (int it = gw; it < (MTOK / 32) * NHEAD; it += NGW) {
            const int mb = it / NHEAD, h = it % NHEAD, m0 = mb * 32, b = m0 / SEQ, s0 = m0 % SEQ;
#pragma unroll
            for (int i = 0; i < 8; ++i) { const int r = (lane >> 4) + 4 * i, c = (lane & 15) * 8;
                const u32x4 w = *(const u32x4*)(VRAW + (size_t)(m0 + r) * DATT + h * HDIM + c);
                LAS unsigned* d = (LAS unsigned*)(scr + r * 130 + c); d[0] = w.x; d[1] = w.y; d[2] = w.z; d[3] = w.w; }
            asm volatile("s_waitcnt lgkmcnt(0)" ::: "memory");
#pragma unroll
            for (int i2 = 0; i2 < 2; ++i2) { const int d = lane + 64 * i2; unsigned o[16];
#pragma unroll
                for (int s = 0; s < 16; ++s) o[s] = (unsigned)scr[(2 * s) * 130 + d] | ((unsigned)scr[(2 * s + 1) * 130 + d] << 16);
                bf16* dst = VT + ((size_t)(b * NHEAD + h) * HDIM + d) * SEQ + s0;
#pragma unroll
                for (int q = 0; q < 4; ++q) { u32x4 w = {o[4 * q], o[4 * q + 1], o[4 * q + 2], o[4 * q + 3]}; *(u32x4*)(dst + 8 * q) = w; } }
            asm volatile("s_waitcnt lgkmcnt(0)" ::: "memory");
        }
    }
    for (int it = gtid; it < MTOK * 128; it += NGT) {
        const int m = it >> 7, cc = (it & 127) * 8, s = m % SEQ, w = 2 << (cc >> 8), cnt = (s + 1 < w) ? s + 1 : w;
        float acc[8] = {0.f, 0.f, 0.f, 0.f, 0.f, 0.f, 0.f, 0.f}, self[8];
        for (int i = 0; i < cnt; ++i) { const u32x4 u = *(const u32x4*)(U + (size_t)(m - i) * 1024 + cc);
            const float x[8] = {bf_lo(u.x), bf_hi(u.x), bf_lo(u.y), bf_hi(u.y), bf_lo(u.z), bf_hi(u.z), bf_lo(u.w), bf_hi(u.w)};
#pragma unroll
            for (int e = 0; e < 8; ++e) { acc[e] += x[e]; if (i == 0) self[e] = x[e]; } }
        const float inv = 1.0f / (float)cnt;
        u32x4 o; o.x = pk2(acc[0] * inv - self[0], acc[1] * inv - self[1]); o.y = pk2(acc[2] * inv - self[2], acc[3] * inv - self[3]);
        o.z = pk2(acc[4] * inv - self[4], acc[5] * inv - self[5]); o.w = pk2(acc[6] * inv - self[6], acc[7] * inv - self[7]);
        *(u32x4*)(POOLED + (size_t)m * 1024 + cc) = o;
    }
}

constexpr int AT_KB = 64 * 272, AT_VB = 128 * 144;
__device__ __forceinline__ void attn_unit(LAS unsigned char* lds, const bf16* QN, const bf16* KN, const bf16* VT, const float* F2, bf16* A2, int bh, int qb, int tid, int wave, int lane) {
    const int fr = lane & 15, fq = lane >> 4;
    const int q0 = qb * 128, r0 = q0 + 16 * wave, ntiles = 2 * (qb + 1);
    LAS unsigned char* Kb = lds; LAS unsigned char* Vb = lds + 2 * AT_KB; LAS float* Bb = (LAS float*)(lds + 2 * AT_KB + 2 * AT_VB);
    const bf16* Kg = KN + (size_t)bh * SEQ * HDIM; const bf16* Vg = VT + (size_t)bh * HDIM * SEQ; const float* Fg = F2 + (size_t)bh * SEQ;
    bf16x8 qf[4];
#pragma unroll
    for (int kk = 0; kk < 4; ++kk) qf[kk] = *(const bf16x8*)(QN + ((size_t)bh * SEQ + r0 + fr) * HDIM + 32 * kk + 8 * fq);
    f32x4 o[8];
#pragma unroll
    for (int db = 0; db < 8; ++db) o[db] = (f32x4){0.f, 0.f, 0.f, 0.f};
    float mrun = -1e30f, lrun = 0.f;
    const int kr0 = tid >> 4, kc = tid & 15, vd0 = tid >> 3, vc = tid & 7;
    u32x4 sk0, sk1, sv0, sv1; float sb = 0.f;
#define AT_LOAD(j) do { const bf16* kp = Kg + (size_t)(64 * (j) + kr0) * HDIM + kc * 8; sk0 = *(const u32x4*)kp; sk1 = *(const u32x4*)(kp + 32 * HDIM); \
        const bf16* vp = Vg + (size_t)vd0 * SEQ + 64 * (j) + vc * 8; sv0 = *(const u32x4*)vp; sv1 = *(const u32x4*)(vp + (size_t)64 * SEQ); \
        if (tid < 64) sb = -Fg[64 * (j) + tid]; } while (0)
#define AT_STORE(buf) do { LAS unsigned char* kd = Kb + (buf) * AT_KB + kr0 * 272 + kc * 16; *(LAS u32x4*)kd = sk0; *(LAS u32x4*)(kd + 32 * 272) = sk1; \
        LAS unsigned char* vd = Vb + (buf) * AT_VB + vd0 * 144 + vc * 16; *(LAS u32x4*)vd = sv0; *(LAS u32x4*)(vd + 64 * 144) = sv1; \
        if (tid < 64) Bb[(buf) * 64 + tid] = sb; } while (0)
    AT_LOAD(0); AT_STORE(0); __syncthreads();
    for (int j = 0; j < ntiles; ++j) {
        const int buf = j & 1, kb = 64 * j;
        if (j + 1 < ntiles) AT_LOAD(j + 1);
        if (kb <= r0 + 15) {
            const LAS unsigned char* K_ = Kb + buf * AT_KB + fr * 272 + 16 * fq; const LAS unsigned char* V_ = Vb + buf * AT_VB + fr * 144 + 8 * fq; const LAS float* B_ = Bb + buf * 64 + 4 * fq;
            f32x4 s[4];
#pragma unroll
            for (int blk = 0; blk < 4; ++blk) s[blk] = *(const LAS f32x4*)(B_ + 16 * blk);
#pragma unroll
            for (int kk = 0; kk < 4; ++kk)
#pragma unroll
                for (int blk = 0; blk < 4; ++blk) { const bf16x8 a = *(const LAS bf16x8*)(K_ + blk * 16 * 272 + 64 * kk); s[blk] = __builtin_amdgcn_mfma_f32_16x16x32_bf16(a, qf[kk], s[blk], 0, 0, 0); }
            if (kb + 63 > r0) { const int qrow = r0 + fr;
#pragma unroll
                for (int blk = 0; blk < 4; ++blk)
#pragma unroll
                    for (int jj = 0; jj < 4; ++jj) if (kb + 16 * blk + 4 * fq + jj > qrow) s[blk][jj] = -__builtin_inff(); }
            float mx = s[0][0];
#pragma unroll
            for (int blk = 0; blk < 4; ++blk)
#pragma unroll
                for (int jj = 0; jj < 4; ++jj) mx = fmaxf(mx, s[blk][jj]);
            mx = fmaxf(mx, __shfl_xor(mx, 16)); mx = fmaxf(mx, __shfl_xor(mx, 32));
            const float mnew = fmaxf(mrun, mx), alpha = __builtin_amdgcn_exp2f(mrun - mnew); mrun = mnew;
            float ps = 0.f;
#pragma unroll
            for (int blk = 0; blk < 4; ++blk)
#pragma unroll
                for (int jj = 0; jj < 4; ++jj) { const float p = __builtin_amdgcn_exp2f(s[blk][jj] - mnew); s[blk][jj] = p; ps += p; }
            lrun = lrun * alpha + ps;
#pragma unroll
            for (int db = 0; db < 8; ++db) o[db] *= alpha;
            bf16x8 pb[2];
#pragma unroll
            for (int k2 = 0; k2 < 2; ++k2) { u32x4 w; w.x = pk2(s[2 * k2][0], s[2 * k2][1]); w.y = pk2(s[2 * k2][2], s[2 * k2][3]); w.z = pk2(s[2 * k2 + 1][0], s[2 * k2 + 1][1]); w.w = pk2(s[2 * k2 + 1][2], s[2 * k2 + 1][3]);
                pb[k2] = __builtin_bit_cast(bf16x8, w); }
#pragma unroll
            for (int db = 0; db < 8; ++db)
#pragma unroll
                for (int k2 = 0; k2 < 2; ++k2) { const u32x2 lo = *(const LAS u32x2*)(V_ + db * 16 * 144 + 64 * k2), hi = *(const LAS u32x2*)(V_ + db * 16 * 144 + 64 * k2 + 32);
                    const u32x4 w = {lo.x, lo.y, hi.x, hi.y}; o[db] = __builtin_amdgcn_mfma_f32_16x16x32_bf16(__builtin_bit_cast(bf16x8, w), pb[k2], o[db], 0, 0, 0); }
        }
        if (j + 1 < ntiles) AT_STORE(buf ^ 1);
        __syncthreads();
    }
#undef AT_LOAD
#undef AT_STORE
    float lt = lrun + __shfl_xor(lrun, 16); lt += __shfl_xor(lt, 32);
    const float inv = 1.0f / lt;
    const int b = bh >> 3, h = bh & 7;
    bf16* op = A2 + (size_t)(b * SEQ + r0 + fr) * DM + h * HDIM + 4 * fq;
#pragma unroll
    for (int db = 0; db < 8; ++db) { const f32x4 v = o[db] * inv; u32x2 w; w.x = pk2(v[0], v[1]); w.y = pk2(v[2], v[3]); *(u32x2*)(op + 16 * db) = w; }
}

#define XB_TMO      128
#define XB_XCNT(j)  (256  + 64 * (j))
#define XB_XSUB(j)  (1280 + 64 * (j))
#define XB_XGEN(j)  (2304 + 64 * (j))
#define XB_TOP      3328
#define XB_TOPGEN   3392
#define XCD_BAR_WORDS 3456
#define XB_SPIN_CAP (1u << 18)

__device__ __forceinline__ unsigned xb_ld(unsigned* p)              { return __hip_atomic_load(p, __ATOMIC_RELAXED, __HIP_MEMORY_SCOPE_AGENT); }
__device__ __forceinline__ unsigned xb_add(unsigned* p, unsigned v) { return __hip_atomic_fetch_add(p, v, __ATOMIC_RELAXED, __HIP_MEMORY_SCOPE_AGENT); }
__device__ __forceinline__ unsigned xb_xcc_id() { return (unsigned)__builtin_amdgcn_s_getreg((3 << 11) | 20) & 0xFu; }
#define XB_SPIN(cond, bar) do { unsigned _sp = 0; while (cond) { __builtin_amdgcn_s_sleep(1); \
    if ((++_sp & 255u) == 0u) { if (xb_ld(&(bar)[XB_TMO])) break; if (_sp > XB_SPIN_CAP) { atomicAdd(&(bar)[XB_TMO], 1u); break; } } } } while (0)

struct XcdBarrier {
    unsigned* bar; unsigned x;
    volatile LAS unsigned* st;
};

__device__ __forceinline__ XcdBarrier xcd_barrier_post(unsigned* bar, volatile LAS unsigned* st) {
    XcdBarrier b; b.bar = bar; b.x = xb_xcc_id(); b.st = st;
    if (threadIdx.x == 0) (void)xb_add(&bar[XB_XCNT(b.x)], 1u);
    return b;
}
__device__ __forceinline__ void xcd_barrier_complete(unsigned* bar, unsigned x, unsigned& nloc, unsigned& nx) {
    const unsigned G = gridDim.x * gridDim.y * gridDim.z;
    unsigned sum, cnt, mine, sp = 0u;
    for (;;) {
        sum = 0u; cnt = 0u; mine = 0u;
#pragma unroll
        for (unsigned j = 0; j < 16; ++j) { const unsigned c = xb_ld(&bar[XB_XCNT(j)]); sum += c; cnt += (c > 0u) ? 1u : 0u; mine = (j == x) ? c : mine; }
        if (sum == G) break;
        __builtin_amdgcn_s_sleep(1);
        if ((++sp & 255u) == 0u) { if (xb_ld(&bar[XB_TMO])) break; if (sp > XB_SPIN_CAP) { atomicAdd(&bar[XB_TMO], 1u); break; } }
    }
    nloc = mine > 0u ? mine : 1u; nx = cnt > 0u ? cnt : 1u;
}

__device__ __forceinline__ void xcd_barrier(const XcdBarrier& b) {
    asm volatile("s_waitcnt vmcnt(0)" ::: "memory");
    __syncthreads();
    if (threadIdx.x == 0) {
        unsigned* bar = b.bar;
        __builtin_amdgcn_s_waitcnt(0);
        unsigned nloc = b.st[0], nx = b.st[1];
        if (nloc == 0u) { xcd_barrier_complete(bar, b.x, nloc, nx); b.st[0] = nloc; b.st[1] = nx; }
        const unsigned old = xb_add(&bar[XB_XSUB(b.x)], 1u);
        const unsigned gen = old / nloc;
        if (old + 1u == (gen + 1u) * nloc) {
            __builtin_amdgcn_fence(__ATOMIC_RELEASE, "agent");
            asm volatile("s_waitcnt vmcnt(0)" ::: "memory");
            const unsigned og = xb_add(&bar[XB_TOP], 1u);
            const unsigned tg = og / nx;
            if (og + 1u == (tg + 1u) * nx) xb_add(&bar[XB_TOPGEN], 1u);
            else XB_SPIN(xb_ld(&bar[XB_TOPGEN]) == tg, bar);
            __builtin_amdgcn_fence(__ATOMIC_ACQUIRE, "agent");
            xb_add(&bar[XB_XGEN(b.x)], 1u);
            asm volatile("s_waitcnt vmcnt(0)" ::: "memory");
        } else {
            XB_SPIN(xb_ld(&bar[XB_XGEN(b.x)]) == gen, bar);
            __builtin_amdgcn_fence(__ATOMIC_ACQUIRE, "agent");
            asm volatile("s_waitcnt vmcnt(0)" ::: "memory");
        }
    }
    __syncthreads();
}

__global__ void __launch_bounds__(NTHREADS, 2) mk_fwd(Ptrs P) {
    extern __shared__ __attribute__((aligned(16))) unsigned char lds_raw[];
    LAS unsigned char* lds = (LAS unsigned char*)lds_raw;
    cg::grid_group grid = cg::this_grid();
    const int tid = threadIdx.x, lane = tid & 63, wave = __builtin_amdgcn_readfirstlane(tid >> 6);
    const int G = gridDim.x, blk = blockIdx.x;
    const int gw = blk * NWAVES + wave, NGW = G * NWAVES, gtid = blk * NTHREADS + tid, NGT = G * NTHREADS;
    unsigned char* ws = P.ws;
    if (ws == nullptr) grid.sync();
    volatile LAS unsigned* misc = (volatile LAS unsigned*)(lds + 131072 + 320);
    if (tid < 32) misc[tid] = 0u;
    __syncthreads();
    const XcdBarrier bar = xcd_barrier_post((unsigned*)(ws + WS_CTL), misc + 8);
    float* MOD = (float*)(ws + WS_MOD); float* LOGF = (float*)(ws + WS_LOGF); float* F2 = (float*)(ws + WS_F2);
    bf16* H = (bf16*)(ws + WS_H); bf16* ACT = (bf16*)(ws + WS_ACT); bf16* A2 = (bf16*)(ws + WS_A2);
    const float* x = P.in[0]; float* out = P.out;
#ifndef REP_SYNC
#define REP_SYNC 1
#endif
#ifndef REP_P0
#define REP_P0 1
#endif
#ifndef REP_ATT
#define REP_ATT 1
#endif
#define GRID_SYNC() do { for (int _r = 0; _r < REP_SYNC; ++_r) xcd_barrier(bar); } while (0)

    for (int rep = 0; rep < REP_P0; ++rep) {
    p0_mod(P.in[1], P.in[2], P.in[3], MOD, (LAS float*)lds, G, blk, tid);
    p0_convert(P, (LAS float*)(lds + wave * 16384), gw, NGW, lane);
    __syncthreads(); }
    GRID_SYNC();
    norm_mod_phase<false>(x, H, P.in[4], MOD + 0 * DM, MOD + 1 * DM, nullptr, nullptr, nullptr, gw, NGW, lane);
    GRID_SYNC();
    { pg8::Gemm g{H, (const bf16*)(ws + WS_W1I), DM, DM, DM, 0}; pg8::StaticOrder S; S.init(MTOK, NFF2, G, blk); pg8::EpiSwiglu E{ACT, DFF};
      pg8::gemm_phase<pg8::EpiSwiglu, pg8::StaticOrder, true, true>(lds, g, S, E); }
    GRID_SYNC();
    { pg8::Gemm g{ACT, (const bf16*)(ws + WS_W1O), DFF, DFF, DFF, 0}; pg8::StaticOrder S; S.init(MTOK, DM, G, blk); pg8::EpiResid E{x, out, DM, MOD + 2 * DM, NMOD, SEQ, 0.5f};
      pg8::gemm_phase<pg8::EpiResid, pg8::StaticOrder, true, true>(lds, g, S, E); }
    GRID_SYNC();
    { LAS float* wf = (LAS float*)lds;
      for (int i = tid; i < DM * 8; i += NTHREADS) { const int k = i >> 3, h = i & 7; wf[h * DM + k] = P.in[8][(size_t)k * DINP + 3 * DATT + h]; }
      __syncthreads();
      norm_mod_phase<true>(out, H, P.in[7], MOD + 3 * DM, MOD + 4 * DM, wf, P.in[9], LOGF, gw, NGW, lane); }
    GRID_SYNC();
    if (blk < NBATCH * NHEAD) cumsum_bh(LOGF, F2, blk, (LAS double*)lds, tid, wave, lane);
    { pg8::Gemm g{H, (const bf16*)(ws + WS_WIN), DM, DM, DM, 0}; pg8::StaticOrder S; S.init(MTOK, 4 * DATT, G, blk); pg8::EpiBf16 E{(bf16*)(ws + WS_QRAW), DATT, DATT, (WS_KRAW - WS_QRAW) / 2};
      pg8::gemm_phase<pg8::EpiBf16, pg8::StaticOrder, true, true>(lds, g, S, E); }
    GRID_SYNC();
    prep_phase(P, lds, gw, NGW, wave, lane, gtid, NGT);
    GRID_SYNC();
    for (int rep = 0; rep < REP_ATT; ++rep)
    for (int it = blk; it < 256; it += G) { const int bh = it & 15, pi = it >> 4;
        attn_unit(lds, (const bf16*)(ws + WS_QN), (const bf16*)(ws + WS_KN), (const bf16*)(ws + WS_VT), F2, A2, bh, pi, tid, wave, lane);
        attn_unit(lds, (const bf16*)(ws + WS_QN), (const bf16*)(ws + WS_KN), (const bf16*)(ws + WS_VT), F2, A2, bh, 31 - pi, tid, wave, lane); }
    { pg8::Gemm g{(const bf16*)(ws + WS_POOLED), (const bf16*)(ws + WS_WPOOL), 1024, 256, 256, 512}; pg8::StaticOrder S; S.init(MTOK, 1024, G, blk); pg8::EpiBf16 E{A2 + 1024, DM, 0, 0};
      pg8::gemm_phase<pg8::EpiBf16, pg8::StaticOrder, true, true>(lds, g, S, E); }
    GRID_SYNC();
    { pg8::Gemm g{A2, (const bf16*)(ws + WS_WOUT), DM, DM, DM, 0}; pg8::StaticOrder S; S.init(MTOK, DM, G, blk); pg8::EpiResid E{out, out, DM, MOD + 5 * DM, NMOD, SEQ, 1.0f};
      pg8::gemm_phase<pg8::EpiResid, pg8::StaticOrder, true, true>(lds, g, S, E); }
    GRID_SYNC();
    norm_mod_phase<false>(out, H, P.in[15], MOD + 6 * DM, MOD + 7 * DM, nullptr, nullptr, nullptr, gw, NGW, lane);
    GRID_SYNC();
    { pg8::Gemm g{H, (const bf16*)(ws + WS_W2I), DM, DM, DM, 0}; pg8::StaticOrder S; S.init(MTOK, NFF2, G, blk); pg8::EpiSwiglu E{ACT, DFF};
      pg8::gemm_phase<pg8::EpiSwiglu, pg8::StaticOrder, true, true>(lds, g, S, E); }
    GRID_SYNC();
    { pg8::Gemm g{ACT, (const bf16*)(ws + WS_W2O), DFF, DFF, DFF, 0}; pg8::StaticOrder S; S.init(MTOK, DM, G, blk); pg8::EpiResid E{out, out, DM, MOD + 8 * DM, NMOD, SEQ, 0.5f};
      pg8::gemm_phase<pg8::EpiResid, pg8::StaticOrder, true, true>(lds, g, S, E); }
    GRID_SYNC();
    final_norm_phase(out, P.in[18], gw, NGW, lane);
}

extern "C" void kernel_launch(void* const* d_in, const int* in_sizes, int n_in, void* d_out, int out_size, void* d_ws, size_t ws_size, hipStream_t stream) {
    static int grid = 0;
    if (grid == 0) {
        if (n_in != 19 || out_size != MTOK * DM || ws_size < WS_END) { fprintf(stderr, "kernel_launch: unexpected shapes (n_in %d, out %d, ws %zu)\n", n_in, out_size, ws_size); grid = -1; return; }
        int dev = 0, cus = 0, per_cu = 0;
        hipGetDevice(&dev); hipDeviceGetAttribute(&cus, hipDeviceAttributeMultiprocessorCount, dev);
        if (hipFuncSetAttribute((const void*)mk_fwd, hipFuncAttributeMaxDynamicSharedMemorySize, LDS_BYTES) != hipSuccess) { fprintf(stderr, "kernel_launch: hipFuncSetAttribute failed\n"); grid = -1; return; }
        if (hipOccupancyMaxActiveBlocksPerMultiprocessor(&per_cu, (const void*)mk_fwd, NTHREADS, LDS_BYTES) != hipSuccess || per_cu < 1) { fprintf(stderr, "kernel_launch: occupancy query failed (%d)\n", per_cu); (void)hipGetLastError(); per_cu = 1; }
        grid = cus * (per_cu > 1 ? 1 : per_cu);
        if (grid < 1) grid = -1;
    }
    if (grid < 0) return;
    if (hipMemsetAsync((char*)d_ws + WS_CTL, 0, 16384, stream) != hipSuccess) { fprintf(stderr, "kernel_launch: memset failed\n"); return; }
    Ptrs p{};
    for (int i = 0; i < 19; ++i) p.in[i] = (const float*)d_in[i];
    p.out = (float*)d_out; p.ws = (unsigned char*)d_ws;
    void* args[] = {&p};
    hipError_t e = hipLaunchCooperativeKernel((const void*)mk_fwd, dim3(grid), dim3(NTHREADS), args, LDS_BYTES, stream);
    if (e != hipSuccess) fprintf(stderr, "cooperative launch failed: %s (grid %d)\n", hipGetErrorString(e), grid);
}
```

```cpp
#include <hip/hip_runtime.h>
#include <hip/hip_cooperative_groups.h>
#include <cstdio>
#include <cstdint>
namespace cg = cooperative_groups;

namespace pg8 {
#define PG8_LAS __attribute__((address_space(3)))
typedef unsigned short bf16_t;
typedef short bf16x8 __attribute__((ext_vector_type(8)));
typedef float f32x4 __attribute__((ext_vector_type(4)));
typedef unsigned u32x4 __attribute__((ext_vector_type(4)));
constexpr int BM = 256, BK = 64, HALF = 128, HTB = HALF * BK * 2  , STAGE_BYTES = 8 * HTB, NXCD = 8, WGM = 8;

__host__ __device__ __forceinline__ int lds_byte(int r, int c) { const int st = (r >> 4) * 2 + (c >> 5), rr = r & 15, cc = c & 31, ob = rr * 64 + cc * 2; return st * 1024 + (ob ^ (((ob >> 9) & 1) << 5)); }
__host__ __device__ __forceinline__ void stage_rc(int b, int& R, int& C) { const int st = b / 1024, sb = b % 1024, swz = sb ^ (((sb >> 9) & 1) << 5); R = (st >> 1) * 16 + swz / 64; C = (st & 1) * 32 + (swz % 64) / 2; }
__host__ __device__ __forceinline__ int perm32(int rho) { const int n = rho >> 4, i = rho & 15; return 8 * (i >> 2) + 4 * n + (i & 3); }

struct Unit { int pm, pn; };
struct Gemm { const bf16_t* A; const bf16_t* Bt; int lda, ldb, K; size_t a_pn_step; };

struct StaticOrder {
    int nM, nN, nwg, G, c;
    __host__ __device__ void init(int M, int N, int G_, int c_) { nM = M / BM; nN = N / BM; nwg = nM * nN; G = G_; c = c_; }
    __host__ __device__ bool next(int i, Unit& u) const {
        const long L = (long)i * G + c; if (L >= nwg) return false;
        int wgid = (int)L; { const int q = nwg / NXCD, r = nwg % NXCD, xcd = wgid % NXCD, off = wgid / NXCD; wgid = (xcd < r ? xcd * (q + 1) : r * (q + 1) + (xcd - r) * q) + off; }
        const int nig = WGM * nN, gid = wgid / nig, fm = gid * WGM, gsz = (nM - fm) < WGM ? (nM - fm) : WGM;
        u.pm = fm + ((wgid % nig) % gsz); u.pn = (wgid % nig) / gsz; return true;
    }
    __device__ __forceinline__ void a_ready(const Unit&) const {}
    __device__ __forceinline__ void done(const Unit&) const {}
};

__device__ __forceinline__ unsigned cvt_pk_bf16(float lo, float hi) { unsigned r; asm volatile("v_cvt_pk_bf16_f32 %0, %1, %2" : "=v"(r) : "v"(lo), "v"(hi)); return r; }

struct EpiBf16 {
    static constexpr bool PERM = true, AFTER_DRAIN = false;
    bf16_t* O; int ldc; int split_cols; size_t split_stride;
    __device__ __forceinline__ void operator()(const f32x4 (&acc)[2][2][4][2], const Unit& u, int wr, int wc, int fr, int fq) const {
        const int row0 = u.pm * BM + wr * 64 + fr; int colt = u.pn * BM; bf16_t* base = O;
        if (split_cols) { const int t = colt / split_cols; base += (size_t)t * split_stride; colt -= t * split_cols; }
        const int col0 = colt + wc * 32 + 8 * fq;
#pragma unroll
        for (int ai = 0; ai < 2; ++ai)
#pragma unroll
            for (int m = 0; m < 4; ++m) { bf16_t* rowp = base + (size_t)(row0 + ai * HALF + m * 16) * ldc + col0;
#pragma unroll
                for (int bj = 0; bj < 2; ++bj) { const f32x4 v0 = acc[ai][bj][m][0], v1 = acc[ai][bj][m][1];
                    u32x4 w; w.x = cvt_pk_bf16(v0[0], v0[1]); w.y = cvt_pk_bf16(v0[2], v0[3]); w.z = cvt_pk_bf16(v1[0], v1[1]); w.w = cvt_pk_bf16(v1[2], v1[3]);
                    *(u32x4*)(rowp + bj * HALF) = w; } }
    }
};
__device__ __forceinline__ float silu_f(float a) { return a * __builtin_amdgcn_rcpf(1.0f + __builtin_amdgcn_exp2f(-1.4426950408889634f * a)); }
struct EpiSwiglu {
    static constexpr bool PERM = true, AFTER_DRAIN = false;
    bf16_t* O; int ldc;
    __device__ __forceinline__ void operator()(const f32x4 (&acc)[2][2][4][2], const Unit& u, int wr, int wc, int fr, int fq) const {
        const int row0 = u.pm * BM + wr * 64 + fr; const int col0 = u.pn * HALF + wc * 32 + 8 * fq;
#pragma unroll
        for (int ai = 0; ai < 2; ++ai)
#pragma unroll
            for (int m = 0; m < 4; ++m) { bf16_t* rowp = O + (size_t)(row0 + ai * HALF + m * 16) * ldc + col0;
                const f32x4 a0 = acc[ai][0][m][0], a1 = acc[ai][0][m][1], b0 = acc[ai][1][m][0], b1 = acc[ai][1][m][1];
                u32x4 w;
                w.x = cvt_pk_bf16(silu_f(a0[0]) * b0[0], silu_f(a0[1]) * b0[1]); w.y = cvt_pk_bf16(silu_f(a0[2]) * b0[2], silu_f(a0[3]) * b0[3]);
                w.z = cvt_pk_bf16(silu_f(a1[0]) * b1[0], silu_f(a1[1]) * b1[1]); w.w = cvt_pk_bf16(silu_f(a1[2]) * b1[2], silu_f(a1[3]) * b1[3]);
                *(u32x4*)rowp = w; }
    }
};
struct EpiResid {
    static constexpr bool PERM = false, AFTER_DRAIN = false;
    const float* base; float* out; int ldc; const float* gate; int gate_bstride; int rows_per_batch; float coef;
    __device__ __forceinline__ void operator()(const f32x4 (&acc)[2][2][4][2], const Unit& u, int wr, int wc, int fr, int fq) const {
        const int col0 = u.pn * BM + wc * 32 + 4 * fq;
        const float* gp = gate + (size_t)((u.pm * BM) / rows_per_batch) * gate_bstride + col0;
        f32x4 gv[2][2];
#pragma unroll
        for (int bj = 0; bj < 2; ++bj)
#pragma unroll
            for (int n = 0; n < 2; ++n) gv[bj][n] = *(const f32x4*)(gp + bj * HALF + n * 16) * coef;
#pragma unroll
        for (int ai = 0; ai < 2; ++ai)
#pragma unroll
            for (int m = 0; m < 4; ++m) { const size_t off = (size_t)(u.pm * BM + ai * HALF + wr * 64 + m * 16 + fr) * ldc + col0;
#pragma unroll
                for (int bj = 0; bj < 2; ++bj)
#pragma unroll
                    for (int n = 0; n < 2; ++n) { const f32x4 bs = *(const f32x4*)(base + off + bj * HALF + n * 16);
                        *(f32x4*)(out + off + bj * HALF + n * 16) = bs + gv[bj][n] * acc[ai][bj][m][n]; }
                asm volatile("" ::: "memory"); }
    }
};

template <class Epi, class Sched, bool ALIGN_EPI = false, bool SP2 = false>
__device__ __forceinline__ void gemm_phase(PG8_LAS unsigned char* lds, const Gemm g, const Sched& S, const Epi& E) {
    const int tid = threadIdx.x, wid = __builtin_amdgcn_readfirstlane(tid >> 6), lane = tid & 63, wr = wid >> 2, wc = wid & 3, fr = lane & 15, fq = lane >> 4;
    const int K = g.K, nt = K / BK;
    unsigned voffA[2], voffB[2];
#pragma unroll
    for (int i = 0; i < 2; ++i) { int R, C; stage_rc(tid * 16 + i * 8192, R, C); const int Rb = Epi::PERM ? ((R & ~31) + perm32(R & 31)) : R;
        voffA[i] = (unsigned)(R * g.lda + C) * 2u; voffB[i] = (unsigned)(Rb * g.ldb + C) * 2u; }
    const size_t kstep = (size_t)(BK * 2);
    const size_t hstepA = (size_t)HALF * g.lda * 2, hstepB = (size_t)HALF * g.ldb * 2;
    const size_t tstepA = 2 * hstepA, tstepB = 2 * hstepB;
    const unsigned ldsw = (unsigned)wid * 1024u;
    const int aoff = lds_byte(wr * 64 + fr, fq * 8), boff = lds_byte(wc * 32 + fr, fq * 8);
#define PG8_SA(b, h) (((b) * 2 + (h)) * HTB)
#define PG8_SB(b, h) ((4 + (b) * 2 + (h)) * HTB)
#define PG8_STAGE(bufoff, gbase, voff) do { _Pragma("unroll") for (int _i = 0; _i < 2; ++_i) \
        __builtin_amdgcn_global_load_lds((const unsigned*)((const char*)(gbase) + (voff)[_i]), (PG8_LAS unsigned*)(lds + (bufoff) + ldsw + _i * 8192), 16, 0, 0); } while (0)
#define PG8_LDA(dst, b, h) do { _Pragma("unroll") for (int m = 0; m < 4; ++m) _Pragma("unroll") for (int k = 0; k < 2; ++k) dst[m][k] = *(const PG8_LAS bf16x8*)(lds + PG8_SA(b, h) + aoff + m * 2048 + k * 1024); } while (0)
#define PG8_LDB(dst, b, h) do { _Pragma("unroll") for (int n = 0; n < 2; ++n) _Pragma("unroll") for (int k = 0; k < 2; ++k) dst[n][k] = *(const PG8_LAS bf16x8*)(lds + PG8_SB(b, h) + boff + n * 2048 + k * 1024); } while (0)
#define PG8_MMA(ai, bj, At, Bt) do { __builtin_amdgcn_s_setprio(1); _Pragma("unroll") for (int m = 0; m < 4; ++m) _Pragma("unroll") for (int n = 0; n < 2; ++n) _Pragma("unroll") for (int k = 0; k < 2; ++k) \
        acc[ai][bj][m][n] = __builtin_amdgcn_mfma_f32_16x16x32_bf16(Bt[n][k], At[m][k], acc[ai][bj][m][n], 0, 0, 0); __builtin_amdgcn_s_setprio(0); } while (0)
#define PG8_WAIT_V(n) asm volatile("s_waitcnt vmcnt(" #n ")" ::: "memory")
#define PG8_WAIT_L(n) asm volatile("s_waitcnt lgkmcnt(" #n ")" ::: "memory")
#define PG8_BAR __builtin_amdgcn_s_barrier()
#define PG8_SCHED __builtin_amdgcn_sched_barrier(0)
    Unit cur, nxt; int ui = 0;
    if (!S.next(0, cur)) return;
    f32x4 acc[2][2][4][2];
#pragma unroll
    for (int a = 0; a < 2; ++a)
#pragma unroll
        for (int b = 0; b < 2; ++b)
#pragma unroll
            for (int m = 0; m < 4; ++m)
#pragma unroll
                for (int n = 0; n < 2; ++n) acc[a][b][m][n] = (f32x4){0.f, 0.f, 0.f, 0.f};
    bf16x8 At[4][2], B0[2][2], B1[2][2];
    const char* cA = (const char*)g.A + (size_t)cur.pm * tstepA + (size_t)cur.pn * g.a_pn_step; const char* cB = (const char*)g.Bt + (size_t)cur.pn * tstepB;
    S.a_ready(cur);
    if constexpr (SP2) {
        PG8_STAGE(PG8_SB(0, 0), cB, voffB); PG8_STAGE(PG8_SB(0, 1), cB + hstepB, voffB); PG8_STAGE(PG8_SA(0, 0), cA, voffA); PG8_STAGE(PG8_SA(0, 1), cA + hstepA, voffA);
        if (wr == 1) PG8_BAR;
        PG8_WAIT_V(2); PG8_BAR;
        PG8_STAGE(PG8_SB(1, 0), cB + kstep, voffB); PG8_STAGE(PG8_SA(1, 0), cA + kstep, voffA); PG8_STAGE(PG8_SB(1, 1), cB + hstepB + kstep, voffB);
        PG8_WAIT_V(6); PG8_BAR;
    } else {
        PG8_STAGE(PG8_SB(0, 0), cB, voffB); PG8_STAGE(PG8_SA(0, 0), cA, voffA); PG8_STAGE(PG8_SB(0, 1), cB + hstepB, voffB); PG8_STAGE(PG8_SA(0, 1), cA + hstepA, voffA);
        if (wr == 1) PG8_BAR;
        PG8_WAIT_V(4); PG8_BAR;
        PG8_STAGE(PG8_SB(1, 0), cB + kstep, voffB); PG8_STAGE(PG8_SA(1, 0), cA + kstep, voffA); PG8_STAGE(PG8_SB(1, 1), cB + hstepB + kstep, voffB);
        PG8_WAIT_V(6); PG8_BAR;
    }
    for (;;) {
        const bool has_next = S.next(ui + 1, nxt);
        const char* nA = has_next ? (const char*)g.A + (size_t)nxt.pm * tstepA + (size_t)nxt.pn * g.a_pn_step : cA; const char* nB = has_next ? (const char*)g.Bt + (size_t)nxt.pn * tstepB : cB;
        for (int t = 0; t < nt; t += 2) {
            const bool last = (t == nt - 2);
            const char* a1 = cA + (size_t)(t + 1) * kstep;
            const char* a2 = last ? nA : cA + (size_t)(t + 2) * kstep; const char* b2 = last ? nB : cB + (size_t)(t + 2) * kstep;
            const char* a3 = a2 + kstep; const char* b3 = b2 + kstep;
            if (last && has_next) S.a_ready(nxt);
            if constexpr (SP2) {
            PG8_LDB(B0, 0, 0); PG8_LDB(B1, 0, 1); PG8_SCHED; PG8_LDA(At, 0, 0); PG8_STAGE(PG8_SA(1, 1), a1 + hstepA, voffA);
            PG8_WAIT_V(8); PG8_WAIT_L(0); PG8_BAR; PG8_MMA(0, 0, At, B0); PG8_MMA(0, 1, At, B1); PG8_BAR; PG8_SCHED;
            PG8_LDA(At, 0, 1); PG8_STAGE(PG8_SB(0, 0), b2, voffB); PG8_STAGE(PG8_SB(0, 1), b2 + hstepB, voffB); PG8_STAGE(PG8_SA(0, 0), a2, voffA);
            PG8_WAIT_V(8); PG8_WAIT_L(0); PG8_BAR; PG8_MMA(1, 0, At, B0); PG8_MMA(1, 1, At, B1); PG8_BAR; PG8_SCHED;
            PG8_LDB(B0, 1, 0); PG8_LDB(B1, 1, 1); PG8_SCHED; PG8_LDA(At, 1, 0); PG8_STAGE(PG8_SA(0, 1), a2 + hstepA, voffA);
            PG8_WAIT_V(8); PG8_WAIT_L(0); PG8_BAR; PG8_MMA(0, 0, At, B0); PG8_MMA(0, 1, At, B1); PG8_BAR; PG8_SCHED;
            PG8_LDA(At, 1, 1); PG8_STAGE(PG8_SB(1, 0), b3, voffB); PG8_STAGE(PG8_SB(1, 1), b3 + hstepB, voffB); PG8_STAGE(PG8_SA(1, 0), a3, voffA);
            PG8_WAIT_V(8); PG8_WAIT_L(0); PG8_BAR; PG8_MMA(1, 0, At, B0); PG8_MMA(1, 1, At, B1); PG8_BAR; PG8_SCHED;
            } else {
            PG8_LDB(B0, 0, 0); PG8_SCHED; PG8_LDA(At, 0, 0); PG8_STAGE(PG8_SA(1, 1), a1 + hstepA, voffA);
            PG8_WAIT_L(8); PG8_BAR; PG8_WAIT_L(0); PG8_MMA(0, 0, At, B0); PG8_BAR; PG8_SCHED;
            PG8_LDB(B1, 0, 1); PG8_STAGE(PG8_SB(0, 0), b2, voffB);
            PG8_BAR; PG8_WAIT_L(0); PG8_MMA(0, 1, At, B1); PG8_BAR;
            PG8_LDA(At, 0, 1); PG8_STAGE(PG8_SA(0, 0), a2, voffA);
            PG8_BAR; PG8_WAIT_L(0); PG8_MMA(1, 0, At, B0); PG8_BAR; PG8_SCHED;
            PG8_STAGE(PG8_SB(0, 1), b2 + hstepB, voffB);
            PG8_WAIT_V(6); PG8_BAR; PG8_MMA(1, 1, At, B1); PG8_BAR;
            PG8_LDB(B0, 1, 0); PG8_SCHED; PG8_LDA(At, 1, 0); PG8_STAGE(PG8_SA(0, 1), a2 + hstepA, voffA);
            PG8_WAIT_L(8); PG8_BAR; PG8_WAIT_L(0); PG8_MMA(0, 0, At, B0); PG8_BAR; PG8_SCHED;
            PG8_LDB(B1, 1, 1); PG8_STAGE(PG8_SB(1, 0), b3, voffB);
            PG8_BAR; PG8_WAIT_L(0); PG8_MMA(0, 1, At, B1); PG8_BAR;
            PG8_LDA(At, 1, 1); PG8_STAGE(PG8_SA(1, 0), a3, voffA);
            PG8_BAR; PG8_WAIT_L(0); PG8_MMA(1, 0, At, B0); PG8_BAR; PG8_SCHED;
            PG8_STAGE(PG8_SB(1, 1), b3 + hstepB, voffB);
            PG8_WAIT_V(6); PG8_BAR; PG8_MMA(1, 1, At, B1); PG8_BAR;
            }
        }
        if constexpr (ALIGN_EPI) { if (wr == 0) PG8_BAR; }
        if constexpr (!Epi::AFTER_DRAIN) { E(acc, cur, wr, wc, fr, fq); S.done(cur); }
        if (!has_next) break;
#pragma unroll
        for (int a = 0; a < 2; ++a)
#pragma unroll
            for (int b = 0; b < 2; ++b)
#pragma unroll
                for (int m = 0; m < 4; ++m)
#pragma unroll
                    for (int n = 0; n < 2; ++n) acc[a][b][m][n] = (f32x4){0.f, 0.f, 0.f, 0.f};
        cur = nxt; cA = nA; cB = nB; ++ui;
        if constexpr (ALIGN_EPI) { if (wr == 1) PG8_BAR; }
    }
    PG8_WAIT_V(0);
    if constexpr (!ALIGN_EPI) { if (wr == 0) PG8_BAR; }
    PG8_BAR;
    if constexpr (Epi::AFTER_DRAIN) { E.fused(acc, cur, wr, wc, fr, fq, lds, wid, lane); S.done(cur); }
#undef PG8_SA
#undef PG8_SB
#undef PG8_STAGE
#undef PG8_LDA
#undef PG8_LDB
#undef PG8_MMA
#undef PG8_WAIT_V
#undef PG8_WAIT_L
#undef PG8_BAR
#undef PG8_SCHED
}
}

constexpr int DM = 2048, NBATCH = 2, SEQ = 4096, MTOK = NBATCH * SEQ, DFF = 5504, NFF2 = 2 * DFF, DATT = 1024, NHEAD = 8, HDIM = 128;
constexpr int NMOD = 9 * DM, DINP = 3 * DATT + NHEAD + 1024, UOFF = 3 * DATT + NHEAD;
constexpr float EPS = 1e-6f;
constexpr int NTHREADS = 512, NWAVES = 8;
constexpr int LDS_BYTES = 147456;

constexpr size_t MiB = 1u << 20;
constexpr size_t WS_CTL = 0, WS_MOD = 1 * MiB, WS_LOGF = 2 * MiB, WS_F2 = 2 * MiB + 512 * 1024;
constexpr size_t WS_W1I = 4 * MiB, WS_W1O = 48 * MiB, WS_W2I = 72 * MiB, WS_W2O = 116 * MiB, WS_WIN = 140 * MiB, WS_WOUT = 156 * MiB, WS_WPOOL = 164 * MiB;
constexpr size_t WS_H = 168 * MiB, WS_ACT = 200 * MiB, WS_QRAW = 288 * MiB, WS_KRAW = 304 * MiB, WS_VRAW = 320 * MiB, WS_U = 336 * MiB;
constexpr size_t WS_QN = 352 * MiB, WS_KN = 368 * MiB, WS_VT = 384 * MiB, WS_POOLED = 400 * MiB, WS_A2 = 416 * MiB, WS_END = 448 * MiB;

#define LAS __attribute__((address_space(3)))
typedef unsigned short bf16;
typedef float f32x4 __attribute__((ext_vector_type(4)));
typedef short bf16x8 __attribute__((ext_vector_type(8)));
typedef unsigned u32x4 __attribute__((ext_vector_type(4)));
typedef unsigned u32x2 __attribute__((ext_vector_type(2)));

__device__ __forceinline__ unsigned f2bf(float f) { unsigned u = __builtin_bit_cast(unsigned, f); return (u + 0x7fffu + ((u >> 16) & 1u)) >> 16; }
__device__ __forceinline__ unsigned pk2(float lo, float hi) { return pg8::cvt_pk_bf16(lo, hi); }
__device__ __forceinline__ float bf_lo(unsigned w) { return __builtin_bit_cast(float, w << 16); }
__device__ __forceinline__ float bf_hi(unsigned w) { return __builtin_bit_cast(float, w & 0xffff0000u); }
__device__ __forceinline__ float wave_sum(float v) {
#pragma unroll
    for (int o = 1; o < 64; o <<= 1) v += __shfl_xor(v, o);
    return v;
}

__device__ __forceinline__ void p0_mod(const float* c, const float* w_ada, const float* b_ada, float* mod, LAS float* lds, int G, int blk, int tid) {
    LAS float* ca = lds; LAS float* red = lds + 4096;
    for (int i = tid; i < 2 * DM; i += NTHREADS) { const float v = c[i]; ca[i] = v / (1.f + __expf(-v)); }
    __syncthreads();
    const int cgp = tid % 18, rg = tid / 18;
    for (int ch = blk; ch < NMOD / 72; ch += G) {
        f32x4 a0 = {0.f, 0.f, 0.f, 0.f}, a1 = {0.f, 0.f, 0.f, 0.f};
        if (tid < 504) {
            const float* wp = w_ada + (size_t)72 * ch + 4 * cgp;
#pragma unroll 4
            for (int k = rg; k < DM; k += 28) { const f32x4 w = *(const f32x4*)(wp + (size_t)k * NMOD); const float s0 = ca[k], s1 = ca[DM + k]; a0 += w * s0; a1 += w * s1; }
            LAS float* r = red + (rg * 18 + cgp) * 8;
            *(LAS f32x4*)r = a0; *(LAS f32x4*)(r + 4) = a1;
        }
        __syncthreads();
        if (tid < 144) { const int b = tid / 72, n = tid % 72; float s = 0.f;
            for (int r = 0; r < 28; ++r) s += red[(r * 18 + (n >> 2)) * 8 + b * 4 + (n & 3)];
            mod[b * NMOD + 72 * ch + n] = s + b_ada[72 * ch + n]; }
        __syncthreads();
    }
}
__device__ __forceinline__ void transpose_item(const float* W, int ldw, int coff, bf16* WT, int ldt, int r0, int k0, int n0, const float* nscale, LAS float* scr, int lane) {
    { const float* wp = W + (size_t)(k0 + (lane >> 5)) * ldw + coff + n0 + (lane & 31); float t[32];
#pragma unroll
      for (int i = 0; i < 32; ++i) t[i] = wp[(size_t)(2 * i) * ldw];
#pragma unroll
      for (int i = 0; i < 32; ++i) scr[(2 * i + (lane >> 5)) * 33 + (lane & 31)] = t[i]; }
    asm volatile("s_waitcnt lgkmcnt(0)" ::: "memory");
    const int c = lane & 7;
#pragma unroll
    for (int j = 0; j < 4; ++j) { const int n = (lane >> 3) + 8 * j; const LAS float* s = scr + (8 * c) * 33 + n;
        const float sc = nscale ? nscale[n0 + n] : 1.f;
        u32x4 o; o.x = pk2(s[0 * 33] * sc, s[1 * 33] * sc); o.y = pk2(s[2 * 33] * sc, s[3 * 33] * sc); o.z = pk2(s[4 * 33] * sc, s[5 * 33] * sc); o.w = pk2(s[6 * 33] * sc, s[7 * 33] * sc);
        *(u32x4*)(WT + (size_t)(r0 + n) * ldt + k0 + 8 * c) = o; }
    asm volatile("s_waitcnt lgkmcnt(0)" ::: "memory");
}
struct Ptrs {
    const float* in[19]; float* out; unsigned char* ws;
};
template <int LATE> __device__ __forceinline__ void p0_convert(const Ptrs& P, LAS float* scr, int gw, int NGW, int lane) {
    bf16* W1I = (bf16*)(P.ws + WS_W1I); bf16* W1O = (bf16*)(P.ws + WS_W1O); bf16* W2I = (bf16*)(P.ws + WS_W2I); bf16* W2O = (bf16*)(P.ws + WS_W2O);
    bf16* WIN = (bf16*)(P.ws + WS_WIN); bf16* WOUT = (bf16*)(P.ws + WS_WOUT); bf16* WPOOL = (bf16*)(P.ws + WS_WPOOL);
    constexpr int I_FI = (DM / 64) * (NFF2 / 32), I_FO = (DFF / 64) * (DM / 32), I_QKV = (DM / 64) * (3 * DATT / 32), I_U = (DM / 64) * (1024 / 32), I_WO = (DM / 64) * (DM / 32), I_PW = 4 * (256 / 64) * (256 / 32);
    constexpr int NITEMS = I_FI + I_FO + I_QKV + I_U + I_WO + I_PW;
    for (int it = gw; it < (LATE ? I_FI + I_FO : NITEMS); it += NGW) {
        int r = it;
        if (r < I_FI) { const int which = LATE; const int nblk = NFF2 / 32, kb = r / nblk, nb = r % nblk, n0 = 32 * nb;
            const int j = n0 < DFF ? n0 : n0 - DFF; const int r0 = 256 * (j / 128) + (n0 < DFF ? 0 : 128) + (j % 128);
            transpose_item(P.in[which ? 16 : 5] + n0, NFF2, 0, which ? W2I : W1I, DM, r0, 64 * kb, 0, nullptr, scr, lane);
            continue; }
        r -= I_FI;
        if (r < I_FO) { const int which = LATE; const int nblk = DM / 32, kb = r / nblk, nb = r % nblk;
            transpose_item(P.in[which ? 17 : 6] + 32 * nb, DM, 0, (which ? W2O : W1O), DFF, 32 * nb, 64 * kb, 0, nullptr, scr, lane); continue; }
        r -= I_FO;
        if (r < I_QKV) { const int nblk = 3 * DATT / 32, kb = r / nblk, nb = r % nblk;
            transpose_item(P.in[8] + 32 * nb, DINP, 0, WIN, DM, 32 * nb, 64 * kb, 0, nullptr, scr, lane); continue; }
        r -= I_QKV;
        if (r < I_U) { const int nblk = 1024 / 32, kb = r / nblk, nb = r % nblk;
            transpose_item(P.in[8] + UOFF + 32 * nb, DINP, 0, WIN, DM, 3 * DATT + 32 * nb, 64 * kb, 0, nullptr, scr, lane); continue; }
        r -= I_U;
        if (r < I_WO) { const int nblk = DM / 32, kb = r / nblk, nb = r % nblk;
            transpose_item(P.in[14] + 32 * nb, DM, 0, WOUT, DM, 32 * nb, 64 * kb, 0, nullptr, scr, lane); continue; }
        r -= I_WO;
        { const int g = r / 32; r -= g * 32; const int kb = r / 8, nb = r % 8;
            transpose_item(P.in[12] + (size_t)g * 65536 + 32 * nb, 256, 0, WPOOL, 256, g * 256 + 32 * nb, 64 * kb, 0, P.in[13] + g * 256 + 32 * nb, scr, lane); }
    }
}

template <bool FLOGIT>
__device__ __forceinline__ void norm_mod_phase(const float* X, bf16* H, const float* gn, const float* shift, const float* scale, const LAS float* wf, const float* b_forget, float* LOGF, int gw, int NGW, int lane) {
    for (int m = gw; m < MTOK; m += NGW) {
        const int b = m / SEQ;
        const f32x4* xr = (const f32x4*)(X + (size_t)m * DM) + lane;
        f32x4 v[8]; float ss = 0.f;
#pragma unroll
        for (int j = 0; j < 8; ++j) { v[j] = xr[64 * j]; ss += (v[j].x * v[j].x + v[j].y * v[j].y) + (v[j].z * v[j].z + v[j].w * v[j].w); }
        const float rstd = 1.0f / sqrtf(wave_sum(ss) * (1.0f / DM) + EPS);
        const float* shp = shift + b * NMOD + 4 * lane; const float* scp = scale + b * NMOD + 4 * lane; const float* gp = gn + 4 * lane;
        unsigned long long* o8 = (unsigned long long*)(H + (size_t)m * DM) + lane;
#pragma unroll
        for (int j = 0; j < 8; ++j) { const f32x4 g4 = *(const f32x4*)(gp + 256 * j), s4 = *(const f32x4*)(scp + 256 * j), h4 = *(const f32x4*)(shp + 256 * j);
            v[j] = (v[j] * rstd) * g4 * (s4 + 1.0f) + h4;
            o8[64 * j] = (unsigned long long)pk2(v[j].x, v[j].y) | ((unsigned long long)pk2(v[j].z, v[j].w) << 32); }
        if constexpr (FLOGIT) {
            float acc[8];
#pragma unroll
            for (int h = 0; h < 8; ++h) { float a = 0.f;
#pragma unroll
                for (int j = 0; j < 8; ++j) { const f32x4 w = *(const LAS f32x4*)(wf + h * DM + 256 * j + 4 * lane); a += (v[j].x * w.x + v[j].y * w.y) + (v[j].z * w.z + v[j].w * w.w); }
                acc[h] = wave_sum(a); }
            float z = acc[0];
#pragma unroll
            for (int h = 1; h < 8; ++h) z = (lane == h) ? acc[h] : z;
            if (lane < 8) { z += b_forget[lane]; const float ls = fminf(z, 0.f) - log1pf(expf(-fabsf(z))); LOGF[(size_t)(b * NHEAD + lane) * SEQ + (m % SEQ)] = ls; }
        }
    }
}
__device__ __forceinline__ void final_norm_phase(float* X, const float* gn, int gw, int NGW, int lane) {
    for (int m = gw; m < MTOK; m += NGW) {
        f32x4* xr = (f32x4*)(X + (size_t)m * DM) + lane;
        f32x4 v[8]; float ss = 0.f;
#pragma unroll
        for (int j = 0; j < 8; ++j) { v[j] = xr[64 * j]; ss += (v[j].x * v[j].x + v[j].y * v[j].y) + (v[j].z * v[j].z + v[j].w * v[j].w); }
        const float rstd = 1.0f / sqrtf(wave_sum(ss) * (1.0f / DM) + EPS);
#pragma unroll
        for (int j = 0; j < 8; ++j) { const f32x4 g4 = *(const f32x4*)(gn + 4 * lane + 256 * j); xr[64 * j] = (v[j] * rstd) * g4; }
    }
}
__device__ __forceinline__ void cumsum_bh(const float* LOGF, float* F2, int bh, LAS double* sd, int tid, int wave, int lane) {
    const float* src = LOGF + (size_t)bh * SEQ + 8 * tid;
    const f32x4 a = *(const f32x4*)src, b = *(const f32x4*)(src + 4);
    double p[8]; p[0] = a.x; p[1] = p[0] + a.y; p[2] = p[1] + a.z; p[3] = p[2] + a.w; p[4] = p[3] + b.x; p[5] = p[4] + b.y; p[6] = p[5] + b.z; p[7] = p[6] + b.w;
    double t = p[7];
#pragma unroll
    for (int o = 1; o < 64; o <<= 1) { const double n = __shfl_up(t, o); if (lane >= o) t += n; }
    if (lane == 63) sd[wave] = t;
    __syncthreads();
    double off = t - p[7];
    for (int w = 0; w < wave; ++w) off += sd[w];
    const double L2E = -1.4426950408889634;
    f32x4 o0, o1;
    o0.x = (float)((off + p[0]) * L2E); o0.y = (float)((off + p[1]) * L2E); o0.z = (float)((off + p[2]) * L2E); o0.w = (float)((off + p[3]) * L2E);
    o1.x = (float)((off + p[4]) * L2E); o1.y = (float)((off + p[5]) * L2E); o1.z = (float)((off + p[6]) * L2E); o1.w = (float)((off + p[7]) * L2E);
    float* dst = F2 + (size_t)bh * SEQ + 8 * tid;
    *(f32x4*)dst = o0; *(f32x4*)(dst + 4) = o1;
    __syncthreads();
}

__device__ __forceinline__ void prep_phase(const Ptrs& P, LAS unsigned char* lds, int gw, int NGW, int wave, int lane, int gtid, int NGT) {
    const bf16* QRAW = (const bf16*)(P.ws + WS_QRAW); const bf16* VRAW = (const bf16*)(P.ws + WS_VRAW); const bf16* U = (const bf16*)(P.ws + WS_U);
    bf16* QN = (bf16*)(P.ws + WS_QN); bf16* VT = (bf16*)(P.ws + WS_VT); bf16* POOLED = (bf16*)(P.ws + WS_POOLED);
    {
        const int l16 = lane & 15, g4 = lane >> 4;
        const float qs = 0.08838834764831845f * 1.4426950408889634f;
        for (int it = gw; it < MTOK * 16 / 4; it += NGW) {
            const int grp = it * 4 + g4, m = grp >> 4, hh = grp & 15, isk = hh >> 3, h = hh & 7;
            const u32x4 w = *(const u32x4*)(QRAW + (size_t)isk * ((WS_KRAW - WS_QRAW) / 2) + (size_t)m * DATT + h * HDIM + 8 * l16);
            float x[8] = {bf_lo(w.x), bf_hi(w.x), bf_lo(w.y), bf_hi(w.y), bf_lo(w.z), bf_hi(w.z), bf_lo(w.w), bf_hi(w.w)};
            float ss = 0.f;
#pragma unroll
            for (int i = 0; i < 8; ++i) ss += x[i] * x[i];
            ss += __shfl_xor(ss, 1); ss += __shfl_xor(ss, 2); ss += __shfl_xor(ss, 4); ss += __shfl_xor(ss, 8);
            const float rs = (1.0f / sqrtf(ss * (1.0f / HDIM) + EPS)) * (isk ? 1.0f : qs);
            const float* gp = P.in[isk ? 11 : 10] + 8 * l16;
            const f32x4 ga = *(const f32x4*)gp, gb = *(const f32x4*)(gp + 4);
            u32x4 o; o.x = pk2(x[0] * rs * ga.x, x[1] * rs * ga.y); o.y = pk2(x[2] * rs * ga.z, x[3] * rs * ga.w); o.z = pk2(x[4] * rs * gb.x, x[5] * rs * gb.y); o.w = pk2(x[6] * rs * gb.z, x[7] * rs * gb.w);
            const int b = m / SEQ, s = m % SEQ;
            *(u32x4*)(QN + (size_t)isk * ((WS_KN - WS_QN) / 2) + ((size_t)(b * NHEAD + h) * SEQ + s) * HDIM + 8 * l16) = o;
        }
    }
    {
        LAS unsigned short* scr = (LAS unsigned short*)(lds + wave * 8448);
        for (int it = gw; it < (MTOK / 32) * NHEAD; it += NGW) {
            const int mb = it / NHEAD, h = it % NHEAD, m0 = mb * 32, b = m0 / SEQ, s0 = m0 % SEQ;
#pragma unroll
            for (int i = 0; i < 8; ++i) { const int r = (lane >> 4) + 4 * i, c = (lane & 15) * 8;
                const u32x4 w = *(const u32x4*)(VRAW + (size_t)(m0 + r) * DATT + h * HDIM + c);
                LAS unsigned* d = (LAS unsigned*)(scr + r * 130 + c); d[0] = w.x; d[1] = w.y; d[2] = w.z; d[3] = w.w; }
            asm volatile("s_waitcnt lgkmcnt(0)" ::: "memory");
#pragma unroll
            for (int i2 = 0; i2 < 2; ++i2) { const int d = lane + 64 * i2; unsigned o[16];
#pragma unroll
                for (int s = 0; s < 16; ++s) o[s] = (unsigned)scr[(2 * s) * 130 + d] | ((unsigned)scr[(2 * s + 1) * 130 + d] << 16);
                bf16* dst = VT + ((size_t)(b * NHEAD + h) * HDIM + d) * SEQ + s0;
#pragma unroll
                for (int q = 0; q < 4; ++q) { u32x4 w = {o[4 * q], o[4 * q + 1], o[4 * q + 2], o[4 * q + 3]}; *(u32x4*)(dst + 8 * q) = w; } }
            asm volatile("s_waitcnt lgkmcnt(0)" ::: "memory");
        }
    }
    for (int it = gtid; it < MTOK * 128; it += NGT) {
        const int m = it >> 7, cc = (it & 127) * 8, s = m % SEQ, w = 2 << (cc >> 8), cnt = (s + 1 < w) ? s + 1 : w;
        float acc[8] = {0.f, 0.f, 0.f, 0.f, 0.f, 0.f, 0.f, 0.f}, self[8];
        for (int i = 0; i < cnt; ++i) { const u32x4 u = *(const u32x4*)(U + (size_t)(m - i) * 1024 + cc);
            const float x[8] = {bf_lo(u.x), bf_hi(u.x), bf_lo(u.y), bf_hi(u.y), bf_lo(u.z), bf_hi(u.z), bf_lo(u.w), bf_hi(u.w)};
#pragma unroll
            for (int e = 0; e < 8; ++e) { acc[e] += x[e]; if (i == 0) self[e] = x[e]; } }
        const float inv = 1.0f / (float)cnt;
        u32x4 o; o.x = pk2(acc[0] * inv - self[0], acc[1] * inv - self[1]); o.y = pk2(acc[2] * inv - self[2], acc[3] * inv - self[3]);
        o.z = pk2(acc[4] * inv - self[4], acc[5] * inv - self[5]); o.w = pk2(acc[6] * inv - self[6], acc[7] * inv - self[7]);
        *(u32x4*)(POOLED + (size_t)m * 1024 + cc) = o;
    }
}

constexpr int AT2_KB = 128 * 256, AT2_VB = 128 * 256, AT2_BUF = AT2_KB + AT2_VB + 512;
__device__ __forceinline__ float xmax16(float x) { const auto r = __builtin_amdgcn_permlane16_swap(__float_as_uint(x), __float_as_uint(x), false, false); return fmaxf(__uint_as_float(r[0]), __uint_as_float(r[1])); }
__device__ __forceinline__ float xmax32(float x) { const auto r = __builtin_amdgcn_permlane32_swap(__float_as_uint(x), __float_as_uint(x), false, false); return fmaxf(__uint_as_float(r[0]), __uint_as_float(r[1])); }
__device__ __forceinline__ void attn_unit2(LAS unsigned char* lds, const bf16* QN, const bf16* KN, const bf16* VT, const float* F2, bf16* A2, int bh, int qb, int tid, int wave, int lane) {
    const int fr = lane & 15, fq = lane >> 4, rg = wave & 3, kh = wave >> 2;
    const int q0 = qb * 128, R0 = q0 + 32 * rg, nst = qb + 1;
    const bf16* Kg = KN + (size_t)bh * SEQ * HDIM; const bf16* Vg = VT + (size_t)bh * HDIM * SEQ; const float* Fg = F2 + (size_t)bh * SEQ;
    bf16x8 qf[2][4];
#pragma unroll
    for (int g = 0; g < 2; ++g)
#pragma unroll
        for (int kk = 0; kk < 4; ++kk) qf[g][kk] = *(const bf16x8*)(QN + ((size_t)bh * SEQ + R0 + 16 * g + fr) * HDIM + 32 * kk + 8 * fq);
    f32x4 o[2][8];
#pragma unroll
    for (int g = 0; g < 2; ++g)
#pragma unroll
        for (int db = 0; db < 8; ++db) o[g][db] = (f32x4){0.f, 0.f, 0.f, 0.f};
    float mrun[2] = {-1e30f, -1e30f}, lrun[2] = {0.f, 0.f};
    const int srow = 16 * wave + (lane >> 4);
    unsigned kgo[4], vgo[4];
#pragma unroll
    for (int i = 0; i < 4; ++i) { const int r = srow + 4 * i, c = (lane & 15) ^ (r & 15); kgo[i] = (unsigned)(r * HDIM + c * 8); vgo[i] = (unsigned)(r * SEQ + c * 8); }
#define AT_STAGE(st, buf) do { _Pragma("unroll") for (int i = 0; i < 4; ++i) { \
            __builtin_amdgcn_global_load_lds((const unsigned*)(Kg + (size_t)(128 * (st)) * HDIM + kgo[i]), (LAS unsigned*)(lds + (buf) * AT2_BUF + (16 * wave + 4 * i) * 256), 16, 0, 0); \
            __builtin_amdgcn_global_load_lds((const unsigned*)(Vg + (size_t)(128 * (st)) + vgo[i]), (LAS unsigned*)(lds + (buf) * AT2_BUF + AT2_KB + (16 * wave + 4 * i) * 256), 16, 0, 0); } \
            if (wave < 2) __builtin_amdgcn_global_load_lds((const unsigned*)(Fg + 128 * (st) + 64 * wave + lane), (LAS unsigned*)(lds + (buf) * AT2_BUF + AT2_KB + AT2_VB + wave * 256), 4, 0, 0); } while (0)
    unsigned koff[4], voff[2][2];
#pragma unroll
    for (int kk = 0; kk < 4; ++kk) koff[kk] = (unsigned)((64 * kh + fr) * 256 + (((4 * kk) | fq) ^ fr) * 16);
#pragma unroll
    for (int k2 = 0; k2 < 2; ++k2)
#pragma unroll
        for (int hi = 0; hi < 2; ++hi) voff[k2][hi] = (unsigned)(AT2_KB + fr * 256 + (((8 * kh) | (4 * k2) | (2 * hi) | (fq >> 1)) ^ fr) * 16 + 8 * (fq & 1));
    AT_STAGE(0, 0); __syncthreads();
    for (int st = 0; st < nst; ++st) {
        const int buf = st & 1, kb = 128 * st + 64 * kh;
        if (st + 1 < nst) AT_STAGE(st + 1, buf ^ 1);
        if (kb <= R0 + 31) {
            const LAS unsigned char* base = lds + buf * AT2_BUF;
            const LAS float* B_ = (const LAS float*)(base + AT2_KB + AT2_VB) + 64 * kh + 4 * fq;
            f32x4 s[2][4];
#pragma unroll
            for (int blk = 0; blk < 4; ++blk) { const f32x4 bv = *(const LAS f32x4*)(B_ + 16 * blk); s[0][blk] = bv; s[1][blk] = bv; }
#pragma unroll
            for (int kk = 0; kk < 4; ++kk)
#pragma unroll
                for (int blk = 0; blk < 4; ++blk) { const bf16x8 a = *(const LAS bf16x8*)(base + koff[kk] + blk * 16 * 256);
                    s[0][blk] = __builtin_amdgcn_mfma_f32_16x16x32_bf16(a, qf[0][kk], s[0][blk], 0, 0, 0); s[1][blk] = __builtin_amdgcn_mfma_f32_16x16x32_bf16(a, qf[1][kk], s[1][blk], 0, 0, 0); }
            bf16x8 pb[2][2];
#pragma unroll
            for (int g = 0; g < 2; ++g) {
                if (kb + 63 > R0 + 16 * g) { const int qrow = R0 + 16 * g + fr;
#pragma unroll
                    for (int blk = 0; blk < 4; ++blk)
#pragma unroll
                        for (int jj = 0; jj < 4; ++jj) if (kb + 16 * blk + 4 * fq + jj > qrow) s[g][blk][jj] = -__builtin_inff(); }
                float mx = s[g][0][0];
#pragma unroll
                for (int blk = 0; blk < 4; ++blk)
#pragma unroll
                    for (int jj = 0; jj < 4; ++jj) mx = fmaxf(mx, s[g][blk][jj]);
                mx = xmax16(mx); mx = xmax32(mx);
                const float mnew = fmaxf(mrun[g], mx), alpha = __builtin_amdgcn_exp2f(mrun[g] - mnew); mrun[g] = mnew;
                float ps = 0.f;
#pragma unroll
                for (int blk = 0; blk < 4; ++blk)
#pragma unroll
                    for (int jj = 0; jj < 4; ++jj) { const float p = __builtin_amdgcn_exp2f(s[g][blk][jj] - mnew); s[g][blk][jj] = p; ps += p; }
                lrun[g] = lrun[g] * alpha + ps;
#pragma unroll
                for (int db = 0; db < 8; ++db) o[g][db] *= alpha;
#pragma unroll
                for (int k2 = 0; k2 < 2; ++k2) { u32x4 w; w.x = pk2(s[g][2 * k2][0], s[g][2 * k2][1]); w.y = pk2(s[g][2 * k2][2], s[g][2 * k2][3]); w.z = pk2(s[g][2 * k2 + 1][0], s[g][2 * k2 + 1][1]); w.w = pk2(s[g][2 * k2 + 1][2], s[g][2 * k2 + 1][3]);
                    pb[g][k2] = __builtin_bit_cast(bf16x8, w); }
            }
#pragma unroll
            for (int db = 0; db < 8; ++db)
#pragma unroll
                for (int k2 = 0; k2 < 2; ++k2) { const u32x2 lo = *(const LAS u32x2*)(base + voff[k2][0] + db * 16 * 256), hi = *(const LAS u32x2*)(base + voff[k2][1] + db * 16 * 256);
                    const u32x4 w = {lo.x, lo.y, hi.x, hi.y}; const bf16x8 a = __builtin_bit_cast(bf16x8, w);
                    o[0][db] = __builtin_amdgcn_mfma_f32_16x16x32_bf16(a, pb[0][k2], o[0][db], 0, 0, 0); o[1][db] = __builtin_amdgcn_mfma_f32_16x16x32_bf16(a, pb[1][k2], o[1][db], 0, 0, 0); }
        }
        __syncthreads();
    }
#undef AT_STAGE
    float lt[2];
#pragma unroll
    for (int g = 0; g < 2; ++g) { float l = lrun[g] + __shfl_xor(lrun[g], 16); l += __shfl_xor(l, 32); lt[g] = l; }
    LAS f32x4* ob = (LAS f32x4*)lds; LAS float* mlb = (LAS float*)(lds + 65536);
    if (kh == 1) {
#pragma unroll
        for (int g = 0; g < 2; ++g) {
#pragma unroll
            for (int db = 0; db < 8; ++db) ob[((rg * 2 + g) * 8 + db) * 64 + lane] = o[g][db];
            mlb[((rg * 2 + g) * 64 + lane) * 2] = mrun[g]; mlb[((rg * 2 + g) * 64 + lane) * 2 + 1] = lt[g]; }
    }
    __syncthreads();
    if (kh == 0) {
        const int b = bh >> 3, h = bh & 7;
#pragma unroll
        for (int g = 0; g < 2; ++g) {
            const float m1 = mlb[((rg * 2 + g) * 64 + lane) * 2], l1 = mlb[((rg * 2 + g) * 64 + lane) * 2 + 1];
            const float mm = fmaxf(mrun[g], m1), a0 = __builtin_amdgcn_exp2f(mrun[g] - mm), a1 = __builtin_amdgcn_exp2f(m1 - mm);
            const float inv = 1.0f / (lt[g] * a0 + l1 * a1), c0 = a0 * inv, c1 = a1 * inv;
            bf16* op = A2 + (size_t)(b * SEQ + R0 + 16 * g + fr) * DM + h * HDIM + 4 * fq;
#pragma unroll
            for (int db = 0; db < 8; ++db) { const f32x4 v = o[g][db] * c0 + ob[((rg * 2 + g) * 8 + db) * 64 + lane] * c1; u32x2 w; w.x = pk2(v[0], v[1]); w.y = pk2(v[2], v[3]); *(u32x2*)(op + 16 * db) = w; }
        }
    }
    __syncthreads();
}

#define XB_TMO      128
#define XB_XCNT(j)  (256  + 64 * (j))
#define XB_XSUB(j)  (1280 + 64 * (j))
#define XB_XGEN(j)  (2304 + 64 * (j))
#define XB_TOP      3328
#define XB_TOPGEN   3392
#define XCD_BAR_WORDS 3456
#define XB_SPIN_CAP (1u << 18)

__device__ __forceinline__ unsigned xb_ld(unsigned* p)              { return __hip_atomic_load(p, __ATOMIC_RELAXED, __HIP_MEMORY_SCOPE_AGENT); }
__device__ __forceinline__ unsigned xb_add(unsigned* p, unsigned v) { return __hip_atomic_fetch_add(p, v, __ATOMIC_RELAXED, __HIP_MEMORY_SCOPE_AGENT); }
__device__ __forceinline__ unsigned xb_xcc_id() { return (unsigned)__builtin_amdgcn_s_getreg((3 << 11) | 20) & 0xFu; }
#define XB_SPIN(cond, bar) do { unsigned _sp = 0; while (cond) { __builtin_amdgcn_s_sleep(1); \
    if ((++_sp & 255u) == 0u) { if (xb_ld(&(bar)[XB_TMO])) break; if (_sp > XB_SPIN_CAP) { atomicAdd(&(bar)[XB_TMO], 1u); break; } } } } while (0)

struct XcdBarrier {
    unsigned* bar; unsigned x;
    volatile LAS unsigned* st;
};

__device__ __forceinline__ XcdBarrier xcd_barrier_post(unsigned* bar, volatile LAS unsigned* st) {
    XcdBarrier b; b.bar = bar; b.x = xb_xcc_id(); b.st = st;
    if (threadIdx.x == 0) (void)xb_add(&bar[XB_XCNT(b.x)], 1u);
    return b;
}
__device__ __forceinline__ void xcd_barrier_complete(unsigned* bar, unsigned x, unsigned& nloc, unsigned& nx) {
    const unsigned G = gridDim.x * gridDim.y * gridDim.z;
    unsigned sum, cnt, mine, sp = 0u;
    for (;;) {
        sum = 0u; cnt = 0u; mine = 0u;
#pragma unroll
        for (unsigned j = 0; j < 16; ++j) { const unsigned c = xb_ld(&bar[XB_XCNT(j)]); sum += c; cnt += (c > 0u) ? 1u : 0u; mine = (j == x) ? c : mine; }
        if (sum == G) break;
        __builtin_amdgcn_s_sleep(1);
        if ((++sp & 255u) == 0u) { if (xb_ld(&bar[XB_TMO])) break; if (sp > XB_SPIN_CAP) { atomicAdd(&bar[XB_TMO], 1u); break; } }
    }
    nloc = mine > 0u ? mine : 1u; nx = cnt > 0u ? cnt : 1u;
}

__device__ __forceinline__ void xcd_barrier(const XcdBarrier& b) {
    asm volatile("s_waitcnt vmcnt(0)" ::: "memory");
    __syncthreads();
    if (threadIdx.x == 0) {
        unsigned* bar = b.bar;
        __builtin_amdgcn_s_waitcnt(0);
        unsigned nloc = b.st[0], nx = b.st[1];
        if (nloc == 0u) { xcd_barrier_complete(bar, b.x, nloc, nx); b.st[0] = nloc; b.st[1] = nx; }
        const unsigned old = xb_add(&bar[XB_XSUB(b.x)], 1u);
        const unsigned gen = old / nloc;
        if (old + 1u == (gen + 1u) * nloc) {
            __builtin_amdgcn_fence(__ATOMIC_RELEASE, "agent");
            asm volatile("s_waitcnt vmcnt(0)" ::: "memory");
            const unsigned og = xb_add(&bar[XB_TOP], 1u);
            const unsigned tg = og / nx;
            if (og + 1u == (tg + 1u) * nx) xb_add(&bar[XB_TOPGEN], 1u);
            else XB_SPIN(xb_ld(&bar[XB_TOPGEN]) == tg, bar);
            __builtin_amdgcn_fence(__ATOMIC_ACQUIRE, "agent");
            xb_add(&bar[XB_XGEN(b.x)], 1u);
            asm volatile("s_waitcnt vmcnt(0)" ::: "memory");
        } else {
            XB_SPIN(xb_ld(&bar[XB_XGEN(b.x)]) == gen, bar);
            __builtin_amdgcn_fence(__ATOMIC_ACQUIRE, "agent");
            asm volatile("s_waitcnt vmcnt(0)" ::: "memory");
        }
    }
    __syncthreads();
}

__global__ void __launch_bounds__(NTHREADS, 2) mk_fwd(Ptrs P) {
    extern __shared__ __attribute__((aligned(16))) unsigned char lds_raw[];
    LAS unsigned char* lds = (LAS unsigned char*)lds_raw;
    cg::grid_group grid = cg::this_grid();
    const int tid = threadIdx.x, lane = tid & 63, wave = __builtin_amdgcn_readfirstlane(tid >> 6);
    const int G = gridDim.x, blk = blockIdx.x;
    const int gw = blk * NWAVES + wave, NGW = G * NWAVES, gtid = blk * NTHREADS + tid, NGT = G * NTHREADS;
    unsigned char* ws = P.ws;
    if (ws == nullptr) grid.sync();
    volatile LAS unsigned* misc = (volatile LAS unsigned*)(lds + LDS_BYTES - 256);
    if (tid < 32) misc[tid] = 0u;
    __syncthreads();
    const XcdBarrier bar = xcd_barrier_post((unsigned*)(ws + WS_CTL), misc + 8);
    float* MOD = (float*)(ws + WS_MOD); float* LOGF = (float*)(ws + WS_LOGF); float* F2 = (float*)(ws + WS_F2);
    bf16* H = (bf16*)(ws + WS_H); bf16* ACT = (bf16*)(ws + WS_ACT); bf16* A2 = (bf16*)(ws + WS_A2);
    const float* x = P.in[0]; float* out = P.out;
#ifndef REP_SYNC
#define REP_SYNC 1
#endif
#ifndef REP_P0
#define REP_P0 1
#endif
#ifndef REP_ATT
#define REP_ATT 1
#endif
#define GRID_SYNC() do { for (int _r = 0; _r < REP_SYNC; ++_r) xcd_barrier(bar); } while (0)

    for (int rep = 0; rep < REP_P0; ++rep) {
    p0_mod(P.in[1], P.in[2], P.in[3], MOD, (LAS float*)lds, G, blk, tid);
    p0_convert<0>(P, (LAS float*)(lds + wave * 16384), gw, NGW, lane);
    __syncthreads(); }
    GRID_SYNC();
    norm_mod_phase<false>(x, H, P.in[4], MOD + 0 * DM, MOD + 1 * DM, nullptr, nullptr, nullptr, gw, NGW, lane);
    GRID_SYNC();
    { pg8::Gemm g{H, (const bf16*)(ws + WS_W1I), DM, DM, DM, 0}; pg8::StaticOrder S; S.init(MTOK, NFF2, G, blk); pg8::EpiSwiglu E{ACT, DFF};
      pg8::gemm_phase<pg8::EpiSwiglu, pg8::StaticOrder, true, true>(lds, g, S, E);
      const int nfull = (MTOK / 256) * (NFF2 / 256) / G, nrem = (MTOK / 256) * (NFF2 / 256) - nfull * G, nidle = G - nrem;
      if (nrem > 0 && blk >= nrem) { __syncthreads(); p0_convert<1>(P, (LAS float*)(lds + wave * 16384), (blk - nrem) * NWAVES + wave, nidle * NWAVES, lane); }
      else if (nrem == 0) { __syncthreads(); p0_convert<1>(P, (LAS float*)(lds + wave * 16384), gw, NGW, lane); } }
    GRID_SYNC();
    { pg8::Gemm g{ACT, (const bf16*)(ws + WS_W1O), DFF, DFF, DFF, 0}; pg8::StaticOrder S; S.init(MTOK, DM, G, blk); pg8::EpiResid E{x, out, DM, MOD + 2 * DM, NMOD, SEQ, 0.5f};
      pg8::gemm_phase<pg8::EpiResid, pg8::StaticOrder, true, true>(lds, g, S, E); }
    GRID_SYNC();
    { LAS float* wf = (LAS float*)lds;
      for (int i = tid; i < DM * 8; i += NTHREADS) { const int k = i >> 3, h = i & 7; wf[h * DM + k] = P.in[8][(size_t)k * DINP + 3 * DATT + h]; }
      __syncthreads();
      norm_mod_phase<true>(out, H, P.in[7], MOD + 3 * DM, MOD + 4 * DM, wf, P.in[9], LOGF, gw, NGW, lane); }
    GRID_SYNC();
    if (blk < NBATCH * NHEAD) cumsum_bh(LOGF, F2, blk, (LAS double*)lds, tid, wave, lane);
    { pg8::Gemm g{H, (const bf16*)(ws + WS_WIN), DM, DM, DM, 0}; pg8::StaticOrder S; S.init(MTOK, 4 * DATT, G, blk); pg8::EpiBf16 E{(bf16*)(ws + WS_QRAW), DATT, DATT, (WS_KRAW - WS_QRAW) / 2};
      pg8::gemm_phase<pg8::EpiBf16, pg8::StaticOrder, true, true>(lds, g, S, E); }
    GRID_SYNC();
    prep_phase(P, lds, gw, NGW, wave, lane, gtid, NGT);
    GRID_SYNC();
    for (int rep = 0; rep < REP_ATT; ++rep)
    for (int it = blk; it < 256; it += G) { const int bh = it & 15, pi = it >> 4;
        attn_unit2(lds, (const bf16*)(ws + WS_QN), (const bf16*)(ws + WS_KN), (const bf16*)(ws + WS_VT), F2, A2, bh, pi, tid, wave, lane);
        attn_unit2(lds, (const bf16*)(ws + WS_QN), (const bf16*)(ws + WS_KN), (const bf16*)(ws + WS_VT), F2, A2, bh, 31 - pi, tid, wave, lane); }
    { pg8::Gemm g{(const bf16*)(ws + WS_POOLED), (const bf16*)(ws + WS_WPOOL), 1024, 256, 256, 512}; pg8::StaticOrder S; S.init(MTOK, 1024, G, blk); pg8::EpiBf16 E{A2 + 1024, DM, 0, 0};
      pg8::gemm_phase<pg8::EpiBf16, pg8::StaticOrder, true, true>(lds, g, S, E); }
    GRID_SYNC();
    { pg8::Gemm g{A2, (const bf16*)(ws + WS_WOUT), DM, DM, DM, 0}; pg8::StaticOrder S; S.init(MTOK, DM, G, blk); pg8::EpiResid E{out, out, DM, MOD + 5 * DM, NMOD, SEQ, 1.0f};
      pg8::gemm_phase<pg8::EpiResid, pg8::StaticOrder, true, true>(lds, g, S, E); }
    GRID_SYNC();
    norm_mod_phase<false>(out, H, P.in[15], MOD + 6 * DM, MOD + 7 * DM, nullptr, nullptr, nullptr, gw, NGW, lane);
    GRID_SYNC();
    { pg8::Gemm g{H, (const bf16*)(ws + WS_W2I), DM, DM, DM, 0}; pg8::StaticOrder S; S.init(MTOK, NFF2, G, blk); pg8::EpiSwiglu E{ACT, DFF};
      pg8::gemm_phase<pg8::EpiSwiglu, pg8::StaticOrder, true, true>(lds, g, S, E); }
    GRID_SYNC();
    { pg8::Gemm g{ACT, (const bf16*)(ws + WS_W2O), DFF, DFF, DFF, 0}; pg8::StaticOrder S; S.init(MTOK, DM, G, blk); pg8::EpiResid E{out, out, DM, MOD + 8 * DM, NMOD, SEQ, 0.5f};
      pg8::gemm_phase<pg8::EpiResid, pg8::StaticOrder, true, true>(lds, g, S, E); }
    GRID_SYNC();
    final_norm_phase(out, P.in[18], gw, NGW, lane);
}

extern "C" void kernel_launch(void* const* d_in, const int* in_sizes, int n_in, void* d_out, int out_size, void* d_ws, size_t ws_size, hipStream_t stream) {
    static int grid = 0;
    if (grid == 0) {
        if (n_in != 19 || out_size != MTOK * DM || ws_size < WS_END) { fprintf(stderr, "kernel_launch: unexpected shapes (n_in %d, out %d, ws %zu)\n", n_in, out_size, ws_size); grid = -1; return; }
        int dev = 0, cus = 0, per_cu = 0;
        hipGetDevice(&dev); hipDeviceGetAttribute(&cus, hipDeviceAttributeMultiprocessorCount, dev);
        if (hipFuncSetAttribute((const void*)mk_fwd, hipFuncAttributeMaxDynamicSharedMemorySize, LDS_BYTES) != hipSuccess) { fprintf(stderr, "kernel_launch: hipFuncSetAttribute failed\n"); grid = -1; return; }
        if (hipOccupancyMaxActiveBlocksPerMultiprocessor(&per_cu, (const void*)mk_fwd, NTHREADS, LDS_BYTES) != hipSuccess || per_cu < 1) { fprintf(stderr, "kernel_launch: occupancy query failed (%d)\n", per_cu); (void)hipGetLastError(); per_cu = 1; }
        grid = cus * (per_cu > 1 ? 1 : per_cu);
        if (grid < 1) grid = -1;
    }
    if (grid < 0) return;
    if (hipMemsetAsync((char*)d_ws + WS_CTL, 0, 16384, stream) != hipSuccess) { fprintf(stderr, "kernel_launch: memset failed\n"); return; }
    Ptrs p{};
    for (int i = 0; i < 19; ++i) p.in[i] = (const float*)d_in[i];
    p.out = (float*)d_out; p.ws = (unsigned char*)d_ws;
    void* args[] = {&p};
    hipError_t e = hipLaunchCooperativeKernel((const void*)mk_fwd, dim3(grid), dim3(NTHREADS), args, LDS_BYTES, stream);
    if (e != hipSuccess) fprintf(stderr, "cooperative launch failed: %s (grid %d)\n", hipGetErrorString(e), grid);
}
```

```cpp
#include <hip/hip_runtime.h>
#include <hip/hip_cooperative_groups.h>
#include <cstdio>
#include <cstdint>
namespace cg = cooperative_groups;

namespace pg8 {
#define PG8_LAS __attribute__((address_space(3)))
typedef unsigned short bf16_t;
typedef short bf16x8 __attribute__((ext_vector_type(8)));
typedef float f32x4 __attribute__((ext_vector_type(4)));
typedef unsigned u32x4 __attribute__((ext_vector_type(4)));
constexpr int BM = 256, BK = 64, HALF = 128, HTB = HALF * BK * 2  , STAGE_BYTES = 8 * HTB, NXCD = 8, WGM = 8;

__host__ __device__ __forceinline__ int lds_byte(int r, int c) { const int st = (r >> 4) * 2 + (c >> 5), rr = r & 15, cc = c & 31, ob = rr * 64 + cc * 2; return st * 1024 + (ob ^ (((ob >> 9) & 1) << 5)); }
__host__ __device__ __forceinline__ void stage_rc(int b, int& R, int& C) { const int st = b / 1024, sb = b % 1024, swz = sb ^ (((sb >> 9) & 1) << 5); R = (st >> 1) * 16 + swz / 64; C = (st & 1) * 32 + (swz % 64) / 2; }
__host__ __device__ __forceinline__ int perm32(int rho) { const int n = rho >> 4, i = rho & 15; return 8 * (i >> 2) + 4 * n + (i & 3); }

struct Unit { int pm, pn; };
struct Gemm { const bf16_t* A; const bf16_t* Bt; int lda, ldb, K; size_t a_pn_step; };

struct StaticOrder {
    int nM, nN, nwg, G, c;
    __host__ __device__ void init(int M, int N, int G_, int c_) { nM = M / BM; nN = N / BM; nwg = nM * nN; G = G_; c = c_; }
    __host__ __device__ bool next(int i, Unit& u) const {
        const long L = (long)i * G + c; if (L >= nwg) return false;
        int wgid = (int)L; { const int q = nwg / NXCD, r = nwg % NXCD, xcd = wgid % NXCD, off = wgid / NXCD; wgid = (xcd < r ? xcd * (q + 1) : r * (q + 1) + (xcd - r) * q) + off; }
        const int nig = WGM * nN, gid = wgid / nig, fm = gid * WGM, gsz = (nM - fm) < WGM ? (nM - fm) : WGM;
        u.pm = fm + ((wgid % nig) % gsz); u.pn = (wgid % nig) / gsz; return true;
    }
    __device__ __forceinline__ void a_ready(const Unit&) const {}
    __device__ __forceinline__ void done(const Unit&) const {}
};

__device__ __forceinline__ unsigned cvt_pk_bf16(float lo, float hi) { unsigned r; asm volatile("v_cvt_pk_bf16_f32 %0, %1, %2" : "=v"(r) : "v"(lo), "v"(hi)); return r; }

struct EpiBf16 {
    static constexpr bool PERM = true, AFTER_DRAIN = false;
    bf16_t* O; int ldc; int split_cols; size_t split_stride;
    __device__ __forceinline__ void operator()(const f32x4 (&acc)[2][2][4][2], const Unit& u, int wr, int wc, int fr, int fq) const {
        const int row0 = u.pm * BM + wr * 64 + fr; int colt = u.pn * BM; bf16_t* base = O;
        if (split_cols) { const int t = colt / split_cols; base += (size_t)t * split_stride; colt -= t * split_cols; }
        const int col0 = colt + wc * 32 + 8 * fq;
#pragma unroll
        for (int ai = 0; ai < 2; ++ai)
#pragma unroll
            for (int m = 0; m < 4; ++m) { bf16_t* rowp = base + (size_t)(row0 + ai * HALF + m * 16) * ldc + col0;
#pragma unroll
                for (int bj = 0; bj < 2; ++bj) { const f32x4 v0 = acc[ai][bj][m][0], v1 = acc[ai][bj][m][1];
                    u32x4 w; w.x = cvt_pk_bf16(v0[0], v0[1]); w.y = cvt_pk_bf16(v0[2], v0[3]); w.z = cvt_pk_bf16(v1[0], v1[1]); w.w = cvt_pk_bf16(v1[2], v1[3]);
                    *(u32x4*)(rowp + bj * HALF) = w; } }
    }
};
__device__ __forceinline__ float silu_f(float a) { return a * __builtin_amdgcn_rcpf(1.0f + __builtin_amdgcn_exp2f(-1.4426950408889634f * a)); }
struct EpiSwiglu {
    static constexpr bool PERM = true, AFTER_DRAIN = false;
    bf16_t* O; int ldc;
    __device__ __forceinline__ void operator()(const f32x4 (&acc)[2][2][4][2], const Unit& u, int wr, int wc, int fr, int fq) const {
        const int row0 = u.pm * BM + wr * 64 + fr; const int col0 = u.pn * HALF + wc * 32 + 8 * fq;
#pragma unroll
        for (int ai = 0; ai < 2; ++ai)
#pragma unroll
            for (int m = 0; m < 4; ++m) { bf16_t* rowp = O + (size_t)(row0 + ai * HALF + m * 16) * ldc + col0;
                const f32x4 a0 = acc[ai][0][m][0], a1 = acc[ai][0][m][1], b0 = acc[ai][1][m][0], b1 = acc[ai][1][m][1];
                u32x4 w;
                w.x = cvt_pk_bf16(silu_f(a0[0]) * b0[0], silu_f(a0[1]) * b0[1]); w.y = cvt_pk_bf16(silu_f(a0[2]) * b0[2], silu_f(a0[3]) * b0[3]);
                w.z = cvt_pk_bf16(silu_f(a1[0]) * b1[0], silu_f(a1[1]) * b1[1]); w.w = cvt_pk_bf16(silu_f(a1[2]) * b1[2], silu_f(a1[3]) * b1[3]);
                *(u32x4*)rowp = w; }
    }
};
struct EpiResid {
    static constexpr bool PERM = false, AFTER_DRAIN = false;
    const float* base; float* out; int ldc; const float* gate; int gate_bstride; int rows_per_batch; float coef;
    __device__ __forceinline__ void operator()(const f32x4 (&acc)[2][2][4][2], const Unit& u, int wr, int wc, int fr, int fq) const {
        const int col0 = u.pn * BM + wc * 32 + 4 * fq;
        const float* gp = gate + (size_t)((u.pm * BM) / rows_per_batch) * gate_bstride + col0;
        f32x4 gv[2][2];
#pragma unroll
        for (int bj = 0; bj < 2; ++bj)
#pragma unroll
            for (int n = 0; n < 2; ++n) gv[bj][n] = *(const f32x4*)(gp + bj * HALF + n * 16) * coef;
#pragma unroll
        for (int ai = 0; ai < 2; ++ai)
#pragma unroll
            for (int m = 0; m < 4; ++m) { const size_t off = (size_t)(u.pm * BM + ai * HALF + wr * 64 + m * 16 + fr) * ldc + col0;
#pragma unroll
                for (int bj = 0; bj < 2; ++bj)
#pragma unroll
                    for (int n = 0; n < 2; ++n) { const f32x4 bs = *(const f32x4*)(base + off + bj * HALF + n * 16);
                        *(f32x4*)(out + off + bj * HALF + n * 16) = bs + gv[bj][n] * acc[ai][bj][m][n]; }
                asm volatile("" ::: "memory"); }
    }
};

template <class Epi, class Sched, bool ALIGN_EPI = false, bool SP2 = false>
__device__ __forceinline__ void gemm_phase(PG8_LAS unsigned char* lds, const Gemm g, const Sched& S, const Epi& E) {
    int tid = threadIdx.x; asm volatile("" : "+v"(tid));
    const int wid = __builtin_amdgcn_readfirstlane(tid >> 6), lane = tid & 63, wr = wid >> 2, wc = wid & 3, fr = lane & 15, fq = lane >> 4;
    const int K = g.K, nt = K / BK;
    unsigned voffA[2], voffB[2];
#pragma unroll
    for (int i = 0; i < 2; ++i) { int R, C; stage_rc(tid * 16 + i * 8192, R, C); const int Rb = Epi::PERM ? ((R & ~31) + perm32(R & 31)) : R;
        voffA[i] = (unsigned)(R * g.lda + C) * 2u; voffB[i] = (unsigned)(Rb * g.ldb + C) * 2u; }
    const size_t kstep = (size_t)(BK * 2);
    const size_t hstepA = (size_t)HALF * g.lda * 2, hstepB = (size_t)HALF * g.ldb * 2;
    const size_t tstepA = 2 * hstepA, tstepB = 2 * hstepB;
    const unsigned ldsw = (unsigned)wid * 1024u;
    const int aoff = lds_byte(wr * 64 + fr, fq * 8), boff = lds_byte(wc * 32 + fr, fq * 8);
#define PG8_SA(b, h) (((b) * 2 + (h)) * HTB)
#define PG8_SB(b, h) ((4 + (b) * 2 + (h)) * HTB)
#define PG8_STAGE(bufoff, gbase, voff) do { _Pragma("unroll") for (int _i = 0; _i < 2; ++_i) \
        __builtin_amdgcn_global_load_lds((const unsigned*)((const char*)(gbase) + (voff)[_i]), (PG8_LAS unsigned*)(lds + (bufoff) + ldsw + _i * 8192), 16, 0, 0); } while (0)
#define PG8_LDA(dst, b, h) do { _Pragma("unroll") for (int m = 0; m < 4; ++m) _Pragma("unroll") for (int k = 0; k < 2; ++k) dst[m][k] = *(const PG8_LAS bf16x8*)(lds + PG8_SA(b, h) + aoff + m * 2048 + k * 1024); } while (0)
#define PG8_LDB(dst, b, h) do { _Pragma("unroll") for (int n = 0; n < 2; ++n) _Pragma("unroll") for (int k = 0; k < 2; ++k) dst[n][k] = *(const PG8_LAS bf16x8*)(lds + PG8_SB(b, h) + boff + n * 2048 + k * 1024); } while (0)
#define PG8_MMA(ai, bj, At, Bt) do { __builtin_amdgcn_s_setprio(1); _Pragma("unroll") for (int m = 0; m < 4; ++m) _Pragma("unroll") for (int n = 0; n < 2; ++n) _Pragma("unroll") for (int k = 0; k < 2; ++k) \
        acc[ai][bj][m][n] = __builtin_amdgcn_mfma_f32_16x16x32_bf16(Bt[n][k], At[m][k], acc[ai][bj][m][n], 0, 0, 0); __builtin_amdgcn_s_setprio(0); } while (0)
#define PG8_WAIT_V(n) asm volatile("s_waitcnt vmcnt(" #n ")" ::: "memory")
#define PG8_WAIT_L(n) asm volatile("s_waitcnt lgkmcnt(" #n ")" ::: "memory")
#define PG8_BAR __builtin_amdgcn_s_barrier()
#define PG8_SCHED __builtin_amdgcn_sched_barrier(0)
    Unit cur, nxt; int ui = 0;
    if (!S.next(0, cur)) return;
    f32x4 acc[2][2][4][2];
#pragma unroll
    for (int a = 0; a < 2; ++a)
#pragma unroll
        for (int b = 0; b < 2; ++b)
#pragma unroll
            for (int m = 0; m < 4; ++m)
#pragma unroll
                for (int n = 0; n < 2; ++n) acc[a][b][m][n] = (f32x4){0.f, 0.f, 0.f, 0.f};
    bf16x8 At[4][2], B0[2][2], B1[2][2];
    const char* cA = (const char*)g.A + (size_t)cur.pm * tstepA + (size_t)cur.pn * g.a_pn_step; const char* cB = (const char*)g.Bt + (size_t)cur.pn * tstepB;
    S.a_ready(cur);
    if constexpr (SP2) {
        PG8_STAGE(PG8_SB(0, 0), cB, voffB); PG8_STAGE(PG8_SB(0, 1), cB + hstepB, voffB); PG8_STAGE(PG8_SA(0, 0), cA, voffA); PG8_STAGE(PG8_SA(0, 1), cA + hstepA, voffA);
        if (wr == 1) PG8_BAR;
        PG8_WAIT_V(2); PG8_BAR;
        PG8_STAGE(PG8_SB(1, 0), cB + kstep, voffB); PG8_STAGE(PG8_SA(1, 0), cA + kstep, voffA); PG8_STAGE(PG8_SB(1, 1), cB + hstepB + kstep, voffB);
        PG8_WAIT_V(6); PG8_BAR;
    } else {
        PG8_STAGE(PG8_SB(0, 0), cB, voffB); PG8_STAGE(PG8_SA(0, 0), cA, voffA); PG8_STAGE(PG8_SB(0, 1), cB + hstepB, voffB); PG8_STAGE(PG8_SA(0, 1), cA + hstepA, voffA);
        if (wr == 1) PG8_BAR;
        PG8_WAIT_V(4); PG8_BAR;
        PG8_STAGE(PG8_SB(1, 0), cB + kstep, voffB); PG8_STAGE(PG8_SA(1, 0), cA + kstep, voffA); PG8_STAGE(PG8_SB(1, 1), cB + hstepB + kstep, voffB);
        PG8_WAIT_V(6); PG8_BAR;
    }
    for (;;) {
        const bool has_next = S.next(ui + 1, nxt);
        const char* nA = has_next ? (const char*)g.A + (size_t)nxt.pm * tstepA + (size_t)nxt.pn * g.a_pn_step : cA; const char* nB = has_next ? (const char*)g.Bt + (size_t)nxt.pn * tstepB : cB;
        for (int t = 0; t < nt; t += 2) {
            const bool last = (t == nt - 2);
            const char* a1 = cA + (size_t)(t + 1) * kstep;
            const char* a2 = last ? nA : cA + (size_t)(t + 2) * kstep; const char* b2 = last ? nB : cB + (size_t)(t + 2) * kstep;
            const char* a3 = a2 + kstep; const char* b3 = b2 + kstep;
            if (last && has_next) S.a_ready(nxt);
            if constexpr (SP2) {
            PG8_LDB(B0, 0, 0); PG8_LDB(B1, 0, 1); PG8_SCHED; PG8_LDA(At, 0, 0); PG8_STAGE(PG8_SA(1, 1), a1 + hstepA, voffA);
            PG8_WAIT_V(8); PG8_WAIT_L(0); PG8_BAR; PG8_MMA(0, 0, At, B0); PG8_MMA(0, 1, At, B1); PG8_BAR; PG8_SCHED;
            PG8_LDA(At, 0, 1); PG8_STAGE(PG8_SB(0, 0), b2, voffB); PG8_STAGE(PG8_SB(0, 1), b2 + hstepB, voffB); PG8_STAGE(PG8_SA(0, 0), a2, voffA);
            PG8_WAIT_V(8); PG8_WAIT_L(0); PG8_BAR; PG8_MMA(1, 0, At, B0); PG8_MMA(1, 1, At, B1); PG8_BAR; PG8_SCHED;
            PG8_LDB(B0, 1, 0); PG8_LDB(B1, 1, 1); PG8_SCHED; PG8_LDA(At, 1, 0); PG8_STAGE(PG8_SA(0, 1), a2 + hstepA, voffA);
            PG8_WAIT_V(8); PG8_WAIT_L(0); PG8_BAR; PG8_MMA(0, 0, At, B0); PG8_MMA(0, 1, At, B1); PG8_BAR; PG8_SCHED;
            PG8_LDA(At, 1, 1); PG8_STAGE(PG8_SB(1, 0), b3, voffB); PG8_STAGE(PG8_SB(1, 1), b3 + hstepB, voffB); PG8_STAGE(PG8_SA(1, 0), a3, voffA);
            PG8_WAIT_V(8); PG8_WAIT_L(0); PG8_BAR; PG8_MMA(1, 0, At, B0); PG8_MMA(1, 1, At, B1); PG8_BAR; PG8_SCHED;
            } else {
            PG8_LDB(B0, 0, 0); PG8_SCHED; PG8_LDA(At, 0, 0); PG8_STAGE(PG8_SA(1, 1), a1 + hstepA, voffA);
            PG8_WAIT_L(8); PG8_BAR; PG8_WAIT_L(0); PG8_MMA(0, 0, At, B0); PG8_BAR; PG8_SCHED;
            PG8_LDB(B1, 0, 1); PG8_STAGE(PG8_SB(0, 0), b2, voffB);
            PG8_BAR; PG8_WAIT_L(0); PG8_MMA(0, 1, At, B1); PG8_BAR;
            PG8_LDA(At, 0, 1); PG8_STAGE(PG8_SA(0, 0), a2, voffA);
            PG8_BAR; PG8_WAIT_L(0); PG8_MMA(1, 0, At, B0); PG8_BAR; PG8_SCHED;
            PG8_STAGE(PG8_SB(0, 1), b2 + hstepB, voffB);
            PG8_WAIT_V(6); PG8_BAR; PG8_MMA(1, 1, At, B1); PG8_BAR;
            PG8_LDB(B0, 1, 0); PG8_SCHED; PG8_LDA(At, 1, 0); PG8_STAGE(PG8_SA(0, 1), a2 + hstepA, voffA);
            PG8_WAIT_L(8); PG8_BAR; PG8_WAIT_L(0); PG8_MMA(0, 0, At, B0); PG8_BAR; PG8_SCHED;
            PG8_LDB(B1, 1, 1); PG8_STAGE(PG8_SB(1, 0), b3, voffB);
            PG8_BAR; PG8_WAIT_L(0); PG8_MMA(0, 1, At, B1); PG8_BAR;
            PG8_LDA(At, 1, 1); PG8_STAGE(PG8_SA(1, 0), a3, voffA);
            PG8_BAR; PG8_WAIT_L(0); PG8_MMA(1, 0, At, B0); PG8_BAR; PG8_SCHED;
            PG8_STAGE(PG8_SB(1, 1), b3 + hstepB, voffB);
            PG8_WAIT_V(6); PG8_BAR; PG8_MMA(1, 1, At, B1); PG8_BAR;
            }
        }
        if constexpr (ALIGN_EPI) { if (wr == 0) PG8_BAR; }
        if constexpr (!Epi::AFTER_DRAIN) { E(acc, cur, wr, wc, fr, fq); S.done(cur); }
        if (!has_next) break;
#pragma unroll
        for (int a = 0; a < 2; ++a)
#pragma unroll
            for (int b = 0; b < 2; ++b)
#pragma unroll
                for (int m = 0; m < 4; ++m)
#pragma unroll
                    for (int n = 0; n < 2; ++n) acc[a][b][m][n] = (f32x4){0.f, 0.f, 0.f, 0.f};
        cur = nxt; cA = nA; cB = nB; ++ui;
        if constexpr (ALIGN_EPI) { if (wr == 1) PG8_BAR; }
    }
    PG8_WAIT_V(0);
    if constexpr (!ALIGN_EPI) { if (wr == 0) PG8_BAR; }
    PG8_BAR;
    if constexpr (Epi::AFTER_DRAIN) { E.fused(acc, cur, wr, wc, fr, fq, lds, wid, lane); S.done(cur); }
#undef PG8_SA
#undef PG8_SB
#undef PG8_STAGE
#undef PG8_LDA
#undef PG8_LDB
#undef PG8_MMA
#undef PG8_WAIT_V
#undef PG8_WAIT_L
#undef PG8_BAR
#undef PG8_SCHED
}
}

constexpr int DM = 2048, NBATCH = 2, SEQ = 4096, MTOK = NBATCH * SEQ, DFF = 5504, NFF2 = 2 * DFF, DATT = 1024, NHEAD = 8, HDIM = 128;
constexpr int NMOD = 9 * DM, DINP = 3 * DATT + NHEAD + 1024, UOFF = 3 * DATT + NHEAD;
constexpr float EPS = 1e-6f;
constexpr int NTHREADS = 512, NWAVES = 8;
constexpr int LDS_BYTES = 147456;

constexpr size_t MiB = 1u << 20;
constexpr size_t WS_CTL = 0, WS_MOD = 1 * MiB, WS_LOGF = 2 * MiB, WS_F2 = 2 * MiB + 512 * 1024;
constexpr size_t WS_W1I = 4 * MiB, WS_W1O = 48 * MiB, WS_W2I = 72 * MiB, WS_W2O = 116 * MiB, WS_WIN = 140 * MiB, WS_WOUT = 156 * MiB, WS_WPOOL = 164 * MiB;
constexpr size_t WS_H = 168 * MiB, WS_ACT = 200 * MiB, WS_QRAW = 288 * MiB, WS_KRAW = 304 * MiB, WS_VRAW = 320 * MiB, WS_U = 336 * MiB;
constexpr size_t WS_QN = 352 * MiB, WS_KN = 368 * MiB, WS_VT = 384 * MiB, WS_POOLED = 400 * MiB, WS_A2 = 416 * MiB, WS_END = 448 * MiB;

#define LAS __attribute__((address_space(3)))
typedef unsigned short bf16;
typedef float f32x4 __attribute__((ext_vector_type(4)));
typedef short bf16x8 __attribute__((ext_vector_type(8)));
typedef unsigned u32x4 __attribute__((ext_vector_type(4)));
typedef unsigned u32x2 __attribute__((ext_vector_type(2)));

__device__ __forceinline__ unsigned f2bf(float f) { unsigned u = __builtin_bit_cast(unsigned, f); return (u + 0x7fffu + ((u >> 16) & 1u)) >> 16; }
__device__ __forceinline__ unsigned pk2(float lo, float hi) { return pg8::cvt_pk_bf16(lo, hi); }
__device__ __forceinline__ float bf_lo(unsigned w) { return __builtin_bit_cast(float, w << 16); }
__device__ __forceinline__ float bf_hi(unsigned w) { return __builtin_bit_cast(float, w & 0xffff0000u); }
__device__ __forceinline__ float wave_sum(float v) {
#pragma unroll
    for (int o = 1; o < 64; o <<= 1) v += __shfl_xor(v, o);
    return v;
}

__device__ __forceinline__ void p0_mod(const float* c, const float* w_ada, const float* b_ada, float* mod, LAS float* lds, int G, int blk, int tid) {
    LAS float* ca = lds; LAS float* red = lds + 4096;
    for (int i = tid; i < 2 * DM; i += NTHREADS) { const float v = c[i]; ca[i] = v / (1.f + __expf(-v)); }
    __syncthreads();
    const int cgp = tid % 18, rg = tid / 18;
    for (int ch = blk; ch < NMOD / 72; ch += G) {
        f32x4 a0 = {0.f, 0.f, 0.f, 0.f}, a1 = {0.f, 0.f, 0.f, 0.f};
        if (tid < 504) {
            const float* wp = w_ada + (size_t)72 * ch + 4 * cgp;
#pragma unroll 4
            for (int k = rg; k < DM; k += 28) { const f32x4 w = *(const f32x4*)(wp + (size_t)k * NMOD); const float s0 = ca[k], s1 = ca[DM + k]; a0 += w * s0; a1 += w * s1; }
            LAS float* r = red + (rg * 18 + cgp) * 8;
            *(LAS f32x4*)r = a0; *(LAS f32x4*)(r + 4) = a1;
        }
        __syncthreads();
        if (tid < 144) { const int b = tid / 72, n = tid % 72; float s = 0.f;
            for (int r = 0; r < 28; ++r) s += red[(r * 18 + (n >> 2)) * 8 + b * 4 + (n & 3)];
            mod[b * NMOD + 72 * ch + n] = s + b_ada[72 * ch + n]; }
        __syncthreads();
    }
}
__device__ __forceinline__ void transpose_item(const float* W, int ldw, int coff, bf16* WT, int ldt, int r0, int k0, int n0, const float* nscale, LAS float* scr, int lane) {
    { const float* wp = W + (size_t)(k0 + (lane >> 5)) * ldw + coff + n0 + (lane & 31); float t[32];
#pragma unroll
      for (int i = 0; i < 32; ++i) t[i] = wp[(size_t)(2 * i) * ldw];
#pragma unroll
      for (int i = 0; i < 32; ++i) scr[(2 * i + (lane >> 5)) * 33 + (lane & 31)] = t[i]; }
    asm volatile("s_waitcnt lgkmcnt(0)" ::: "memory");
    const int c = lane & 7;
#pragma unroll
    for (int j = 0; j < 4; ++j) { const int n = (lane >> 3) + 8 * j; const LAS float* s = scr + (8 * c) * 33 + n;
        const float sc = nscale ? nscale[n0 + n] : 1.f;
        u32x4 o; o.x = pk2(s[0 * 33] * sc, s[1 * 33] * sc); o.y = pk2(s[2 * 33] * sc, s[3 * 33] * sc); o.z = pk2(s[4 * 33] * sc, s[5 * 33] * sc); o.w = pk2(s[6 * 33] * sc, s[7 * 33] * sc);
        *(u32x4*)(WT + (size_t)(r0 + n) * ldt + k0 + 8 * c) = o; }
    asm volatile("s_waitcnt lgkmcnt(0)" ::: "memory");
}
struct Ptrs {
    const float* in[19]; float* out; unsigned char* ws;
};
template <int LATE> __device__ __forceinline__ void p0_convert(const Ptrs& P, LAS float* scr, int gw, int NGW, int lane) {
    bf16* W1I = (bf16*)(P.ws + WS_W1I); bf16* W1O = (bf16*)(P.ws + WS_W1O); bf16* W2I = (bf16*)(P.ws + WS_W2I); bf16* W2O = (bf16*)(P.ws + WS_W2O);
    bf16* WIN = (bf16*)(P.ws + WS_WIN); bf16* WOUT = (bf16*)(P.ws + WS_WOUT); bf16* WPOOL = (bf16*)(P.ws + WS_WPOOL);
    constexpr int I_FI = (DM / 64) * (NFF2 / 32), I_FO = (DFF / 64) * (DM / 32), I_QKV = (DM / 64) * (3 * DATT / 32), I_U = (DM / 64) * (1024 / 32), I_WO = (DM / 64) * (DM / 32), I_PW = 4 * (256 / 64) * (256 / 32);
    constexpr int NITEMS = I_FI + I_FO + I_QKV + I_U + I_WO + I_PW;
    for (int it = gw; it < (LATE ? I_FI + I_FO : NITEMS); it += NGW) {
        int r = it;
        if (r < I_FI) { const int which = LATE; const int nblk = NFF2 / 32, kb = r / nblk, nb = r % nblk, n0 = 32 * nb;
            const int j = n0 < DFF ? n0 : n0 - DFF; const int r0 = 256 * (j / 128) + (n0 < DFF ? 0 : 128) + (j % 128);
            transpose_item(P.in[which ? 16 : 5] + n0, NFF2, 0, which ? W2I : W1I, DM, r0, 64 * kb, 0, nullptr, scr, lane);
            continue; }
        r -= I_FI;
        if (r < I_FO) { const int which = LATE; const int nblk = DM / 32, kb = r / nblk, nb = r % nblk;
            transpose_item(P.in[which ? 17 : 6] + 32 * nb, DM, 0, (which ? W2O : W1O), DFF, 32 * nb, 64 * kb, 0, nullptr, scr, lane); continue; }
        r -= I_FO;
        if (r < I_QKV) { const int nblk = 3 * DATT / 32, kb = r / nblk, nb = r % nblk;
            transpose_item(P.in[8] + 32 * nb, DINP, 0, WIN, DM, 32 * nb, 64 * kb, 0, nullptr, scr, lane); continue; }
        r -= I_QKV;
        if (r < I_U) { const int nblk = 1024 / 32, kb = r / nblk, nb = r % nblk;
            transpose_item(P.in[8] + UOFF + 32 * nb, DINP, 0, WIN, DM, 3 * DATT + 32 * nb, 64 * kb, 0, nullptr, scr, lane); continue; }
        r -= I_U;
        if (r < I_WO) { const int nblk = DM / 32, kb = r / nblk, nb = r % nblk;
            transpose_item(P.in[14] + 32 * nb, DM, 0, WOUT, DM, 32 * nb, 64 * kb, 0, nullptr, scr, lane); continue; }
        r -= I_WO;
        { const int g = r / 32; r -= g * 32; const int kb = r / 8, nb = r % 8;
            transpose_item(P.in[12] + (size_t)g * 65536 + 32 * nb, 256, 0, WPOOL, 256, g * 256 + 32 * nb, 64 * kb, 0, P.in[13] + g * 256 + 32 * nb, scr, lane); }
    }
}

template <bool FLOGIT>
__device__ __forceinline__ void norm_mod_phase(const float* X, bf16* H, const float* gn, const float* shift, const float* scale, const LAS float* wf, const float* b_forget, float* LOGF, int gw, int NGW, int lane) {
    for (int m = gw; m < MTOK; m += NGW) {
        const int b = m / SEQ;
        const f32x4* xr = (const f32x4*)(X + (size_t)m * DM) + lane;
        f32x4 v[8]; float ss = 0.f;
#pragma unroll
        for (int j = 0; j < 8; ++j) { v[j] = xr[64 * j]; ss += (v[j].x * v[j].x + v[j].y * v[j].y) + (v[j].z * v[j].z + v[j].w * v[j].w); }
        const float rstd = 1.0f / sqrtf(wave_sum(ss) * (1.0f / DM) + EPS);
        const float* shp = shift + b * NMOD + 4 * lane; const float* scp = scale + b * NMOD + 4 * lane; const float* gp = gn + 4 * lane;
        unsigned long long* o8 = (unsigned long long*)(H + (size_t)m * DM) + lane;
#pragma unroll
        for (int j = 0; j < 8; ++j) { const f32x4 g4 = *(const f32x4*)(gp + 256 * j), s4 = *(const f32x4*)(scp + 256 * j), h4 = *(const f32x4*)(shp + 256 * j);
            v[j] = (v[j] * rstd) * g4 * (s4 + 1.0f) + h4;
            o8[64 * j] = (unsigned long long)pk2(v[j].x, v[j].y) | ((unsigned long long)pk2(v[j].z, v[j].w) << 32); }
        if constexpr (FLOGIT) {
            float acc[8];
#pragma unroll
            for (int h = 0; h < 8; ++h) { float a = 0.f;
#pragma unroll
                for (int j = 0; j < 8; ++j) { const f32x4 w = *(const LAS f32x4*)(wf + h * DM + 256 * j + 4 * lane); a += (v[j].x * w.x + v[j].y * w.y) + (v[j].z * w.z + v[j].w * w.w); }
                acc[h] = wave_sum(a); }
            float z = acc[0];
#pragma unroll
            for (int h = 1; h < 8; ++h) z = (lane == h) ? acc[h] : z;
            if (lane < 8) { z += b_forget[lane]; const float ls = fminf(z, 0.f) - log1pf(expf(-fabsf(z))); LOGF[(size_t)(b * NHEAD + lane) * SEQ + (m % SEQ)] = ls; }
        }
    }
}
__device__ __forceinline__ void final_norm_phase(float* X, const float* gn, int gw, int NGW, int lane) {
    for (int m = gw; m < MTOK; m += NGW) {
        f32x4* xr = (f32x4*)(X + (size_t)m * DM) + lane;
        f32x4 v[8]; float ss = 0.f;
#pragma unroll
        for (int j = 0; j < 8; ++j) { v[j] = xr[64 * j]; ss += (v[j].x * v[j].x + v[j].y * v[j].y) + (v[j].z * v[j].z + v[j].w * v[j].w); }
        const float rstd = 1.0f / sqrtf(wave_sum(ss) * (1.0f / DM) + EPS);
#pragma unroll
        for (int j = 0; j < 8; ++j) { const f32x4 g4 = *(const f32x4*)(gn + 4 * lane + 256 * j); xr[64 * j] = (v[j] * rstd) * g4; }
    }
}
__device__ __forceinline__ void cumsum_bh(const float* LOGF, float* F2, int bh, LAS double* sd, int tid, int wave, int lane) {
    const float* src = LOGF + (size_t)bh * SEQ + 8 * tid;
    const f32x4 a = *(const f32x4*)src, b = *(const f32x4*)(src + 4);
    double p[8]; p[0] = a.x; p[1] = p[0] + a.y; p[2] = p[1] + a.z; p[3] = p[2] + a.w; p[4] = p[3] + b.x; p[5] = p[4] + b.y; p[6] = p[5] + b.z; p[7] = p[6] + b.w;
    double t = p[7];
#pragma unroll
    for (int o = 1; o < 64; o <<= 1) { const double n = __shfl_up(t, o); if (lane >= o) t += n; }
    if (lane == 63) sd[wave] = t;
    __syncthreads();
    double off = t - p[7];
    for (int w = 0; w < wave; ++w) off += sd[w];
    const double L2E = -1.4426950408889634;
    f32x4 o0, o1;
    o0.x = (float)((off + p[0]) * L2E); o0.y = (float)((off + p[1]) * L2E); o0.z = (float)((off + p[2]) * L2E); o0.w = (float)((off + p[3]) * L2E);
    o1.x = (float)((off + p[4]) * L2E); o1.y = (float)((off + p[5]) * L2E); o1.z = (float)((off + p[6]) * L2E); o1.w = (float)((off + p[7]) * L2E);
    float* dst = F2 + (size_t)bh * SEQ + 8 * tid;
    *(f32x4*)dst = o0; *(f32x4*)(dst + 4) = o1;
    __syncthreads();
}

__device__ __forceinline__ void prep_phase(const Ptrs& P, LAS unsigned char* lds, int gw, int NGW, int wave, int lane, int gtid, int NGT) {
    const bf16* QRAW = (const bf16*)(P.ws + WS_QRAW); const bf16* VRAW = (const bf16*)(P.ws + WS_VRAW); const bf16* U = (const bf16*)(P.ws + WS_U);
    bf16* QN = (bf16*)(P.ws + WS_QN); bf16* VT = (bf16*)(P.ws + WS_VT); bf16* POOLED = (bf16*)(P.ws + WS_POOLED);
    {
        const int l16 = lane & 15, g4 = lane >> 4;
        const float qs = 0.08838834764831845f * 1.4426950408889634f;
        for (int it = gw; it < MTOK * 16 / 4; it += NGW) {
            const int grp = it * 4 + g4, m = grp >> 4, hh = grp & 15, isk = hh >> 3, h = hh & 7;
            const u32x4 w = *(const u32x4*)(QRAW + (size_t)isk * ((WS_KRAW - WS_QRAW) / 2) + (size_t)m * DATT + h * HDIM + 8 * l16);
            float x[8] = {bf_lo(w.x), bf_hi(w.x), bf_lo(w.y), bf_hi(w.y), bf_lo(w.z), bf_hi(w.z), bf_lo(w.w), bf_hi(w.w)};
            float ss = 0.f;
#pragma unroll
            for (int i = 0; i < 8; ++i) ss += x[i] * x[i];
            ss += __shfl_xor(ss, 1); ss += __shfl_xor(ss, 2); ss += __shfl_xor(ss, 4); ss += __shfl_xor(ss, 8);
            const float rs = (1.0f / sqrtf(ss * (1.0f / HDIM) + EPS)) * (isk ? 1.0f : qs);
            const float* gp = P.in[isk ? 11 : 10] + 8 * l16;
            const f32x4 ga = *(const f32x4*)gp, gb = *(const f32x4*)(gp + 4);
            u32x4 o; o.x = pk2(x[0] * rs * ga.x, x[1] * rs * ga.y); o.y = pk2(x[2] * rs * ga.z, x[3] * rs * ga.w); o.z = pk2(x[4] * rs * gb.x, x[5] * rs * gb.y); o.w = pk2(x[6] * rs * gb.z, x[7] * rs * gb.w);
            const int b = m / SEQ, s = m % SEQ;
            *(u32x4*)(QN + (size_t)isk * ((WS_KN - WS_QN) / 2) + ((size_t)(b * NHEAD + h) * SEQ + s) * HDIM + 8 * l16) = o;
        }
    }
    {
        LAS unsigned short* scr = (LAS unsigned short*)(lds + wave * 8448);
        for (int it = gw; it < (MTOK / 32) * NHEAD; it += NGW) {
            const int mb = it / NHEAD, h = it % NHEAD, m0 = mb * 32, b = m0 / SEQ, s0 = m0 % SEQ;
#pragma unroll
            for (int i = 0; i < 8; ++i) { const int r = (lane >> 4) + 4 * i, c = (lane & 15) * 8;
                const u32x4 w = *(const u32x4*)(VRAW + (size_t)(m0 + r) * DATT + h * HDIM + c);
                LAS unsigned* d = (LAS unsigned*)(scr + r * 130 + c); d[0] = w.x; d[1] = w.y; d[2] = w.z; d[3] = w.w; }
            asm volatile("s_waitcnt lgkmcnt(0)" ::: "memory");
#pragma unroll
            for (int i2 = 0; i2 < 2; ++i2) { const int d = lane + 64 * i2; unsigned o[16];
#pragma unroll
                for (int s = 0; s < 16; ++s) { const int p0 = 2 * s, q = p0 >> 3, i = p0 & 7, k0 = (i < 4) ? 4 * q + i : 16 + 4 * q + (i - 4);
                    o[s] = (unsigned)scr[k0 * 130 + d] | ((unsigned)scr[(k0 + 1) * 130 + d] << 16); }
                bf16* dst = VT + (((size_t)(b * NHEAD + h) * (SEQ / 128) + (s0 >> 7)) * HDIM + d) * 128 + (s0 & 127);
#pragma unroll
                for (int q = 0; q < 4; ++q) { u32x4 w = {o[4 * q], o[4 * q + 1], o[4 * q + 2], o[4 * q + 3]}; *(u32x4*)(dst + 8 * q) = w; } }
            asm volatile("s_waitcnt lgkmcnt(0)" ::: "memory");
        }
    }
    for (int it = gtid; it < MTOK * 128; it += NGT) {
        const int m = it >> 7, cc = (it & 127) * 8, s = m % SEQ, w = 2 << (cc >> 8), cnt = (s + 1 < w) ? s + 1 : w;
        float acc[8] = {0.f, 0.f, 0.f, 0.f, 0.f, 0.f, 0.f, 0.f}, self[8];
        for (int i = 0; i < cnt; ++i) { const u32x4 u = *(const u32x4*)(U + (size_t)(m - i) * 1024 + cc);
            const float x[8] = {bf_lo(u.x), bf_hi(u.x), bf_lo(u.y), bf_hi(u.y), bf_lo(u.z), bf_hi(u.z), bf_lo(u.w), bf_hi(u.w)};
#pragma unroll
            for (int e = 0; e < 8; ++e) { acc[e] += x[e]; if (i == 0) self[e] = x[e]; } }
        const float inv = 1.0f / (float)cnt;
        u32x4 o; o.x = pk2(acc[0] * inv - self[0], acc[1] * inv - self[1]); o.y = pk2(acc[2] * inv - self[2], acc[3] * inv - self[3]);
        o.z = pk2(acc[4] * inv - self[4], acc[5] * inv - self[5]); o.w = pk2(acc[6] * inv - self[6], acc[7] * inv - self[7]);
        *(u32x4*)(POOLED + (size_t)m * 1024 + cc) = o;
    }
}

constexpr int AT2_KB = 128 * 256, AT2_VB = 128 * 256, AT2_BUF = AT2_KB + AT2_VB + 512;
__device__ __forceinline__ float xmax16(float x) { const auto r = __builtin_amdgcn_permlane16_swap(__float_as_uint(x), __float_as_uint(x), false, false); return fmaxf(__uint_as_float(r[0]), __uint_as_float(r[1])); }
__device__ __forceinline__ float xmax32(float x) { const auto r = __builtin_amdgcn_permlane32_swap(__float_as_uint(x), __float_as_uint(x), false, false); return fmaxf(__uint_as_float(r[0]), __uint_as_float(r[1])); }
__device__ __forceinline__ void attn_unit2(LAS unsigned char* lds, const bf16* QN, const bf16* KN, const bf16* VT, const float* F2, bf16* A2, float cref, int bh, int qb, int tid, int wave, int lane) {
    const int fr = lane & 15, fq = lane >> 4, rg = wave & 3, kh = wave >> 2;
    const int q0 = qb * 128, R0 = q0 + 32 * rg, nst = qb + 1;
    const bf16* Kg = KN + (size_t)bh * SEQ * HDIM; const bf16* Vg = VT + (size_t)bh * HDIM * SEQ; const float* Fg = F2 + (size_t)bh * SEQ;
    bf16x8 qf[2][4];
#pragma unroll
    for (int g = 0; g < 2; ++g)
#pragma unroll
        for (int kk = 0; kk < 4; ++kk) qf[g][kk] = *(const bf16x8*)(QN + ((size_t)bh * SEQ + R0 + 16 * g + fr) * HDIM + 32 * kk + 8 * fq);
    f32x4 o[2][8];
#pragma unroll
    for (int g = 0; g < 2; ++g)
#pragma unroll
        for (int db = 0; db < 8; ++db) o[g][db] = (f32x4){0.f, 0.f, 0.f, 0.f};
    float lrun[2] = {0.f, 0.f}, bt[2];
#pragma unroll
    for (int g = 0; g < 2; ++g) bt[g] = Fg[R0 + 16 * g + fr] + cref;
    const unsigned c08 = (unsigned)(((lane & 15) ^ (lane >> 4)) * 8);
    const unsigned srowk = (unsigned)((16 * wave + (lane >> 4)) * HDIM), srowv = (unsigned)((16 * wave + (lane >> 4)) * 128);
#define AT_STAGE(st, buf) do { unsigned c08_ = c08; asm volatile("" : "+v"(c08_)); _Pragma("unroll") for (int i = 0; i < 4; ++i) { const unsigned cx = c08_ ^ (unsigned)(32 * i); \
            __builtin_amdgcn_global_load_lds((const unsigned*)(Kg + (size_t)(128 * (st)) * HDIM + 4 * i * HDIM + (srowk + cx)), (LAS unsigned*)(lds + (buf) * AT2_BUF + (16 * wave + 4 * i) * 256), 16, 0, 0); \
            __builtin_amdgcn_global_load_lds((const unsigned*)(Vg + (size_t)(st) * (128 * HDIM) + 4 * i * 128 + (srowv + cx)), (LAS unsigned*)(lds + (buf) * AT2_BUF + AT2_KB + (16 * wave + 4 * i) * 256), 16, 0, 0); } \
            if (wave < 2) __builtin_amdgcn_global_load_lds((const unsigned*)(Fg + 128 * (st) + 64 * wave + lane), (LAS unsigned*)(lds + (buf) * AT2_BUF + AT2_KB + AT2_VB + wave * 256), 4, 0, 0); } while (0)
    const unsigned kbase0 = (unsigned)((64 * kh + fr) * 256 + ((((fr >> 2) & 3) << 6) | ((fq ^ (fr & 3)) << 4)));
    const unsigned vbase0 = (unsigned)(AT2_KB + fr * 256 + (((8 * kh) | fq) ^ fr) * 16);
    AT_STAGE(0, 0); asm volatile("s_waitcnt vmcnt(0)" ::: "memory"); __syncthreads();
    for (int st = 0; st < nst; ++st) {
        const int buf = st & 1, kb = 128 * st + 64 * kh;
        if (st + 1 < nst) AT_STAGE(st + 1, buf ^ 1);
        if (kb <= R0 + 31) {
            const LAS unsigned char* base = lds + buf * AT2_BUF;
            unsigned kb0 = kbase0, vb0 = vbase0; asm volatile("" : "+v"(kb0), "+v"(vb0));
            const LAS float* B_ = (const LAS float*)(base + AT2_KB + AT2_VB) + 64 * kh + 4 * fq;
            f32x4 s[2][2][2];
            bf16x8 pb[2][2];
            bf16x8 kf[4], vf[4];
#define AT_SB() __builtin_amdgcn_sched_barrier(0)
#define AT_RK(h, b2) do { _Pragma("unroll") for (int kk = 0; kk < 4; ++kk) kf[kk] = *(const LAS bf16x8*)(base + (kb0 ^ (unsigned)(kk << 6)) + (2 * (h) + (b2)) * 16 * 256); } while (0)
#define AT_RV(h, d4) do { _Pragma("unroll") for (int dd = 0; dd < 4; ++dd) vf[dd] = *(const LAS bf16x8*)(base + (vb0 ^ (unsigned)(64 * (h))) + (4 * (d4) + dd) * 16 * 256); } while (0)
#define AT_QK(h, b2) do { { const f32x4 bv = *(const LAS f32x4*)(B_ + 16 * (2 * (h) + (b2))); s[h][0][b2] = bv - bt[0]; s[h][1][b2] = bv - bt[1]; } \
            _Pragma("unroll") for (int kk = 0; kk < 4; ++kk) { \
                s[h][0][b2] = __builtin_amdgcn_mfma_f32_16x16x32_bf16(kf[kk], qf[0][kk], s[h][0][b2], 0, 0, 0); s[h][1][b2] = __builtin_amdgcn_mfma_f32_16x16x32_bf16(kf[kk], qf[1][kk], s[h][1][b2], 0, 0, 0); } } while (0)
#define AT_SM(h) do { _Pragma("unroll") for (int g = 0; g < 2; ++g) { \
            if (kb + 32 * (h) + 31 > R0 + 16 * g) { const int qrow = R0 + 16 * g + fr; \
                _Pragma("unroll") for (int b2 = 0; b2 < 2; ++b2) _Pragma("unroll") for (int jj = 0; jj < 4; ++jj) if (kb + 32 * (h) + 16 * b2 + 4 * fq + jj > qrow) s[h][g][b2][jj] = -__builtin_inff(); } \
            float ps = 0.f; \
            _Pragma("unroll") for (int b2 = 0; b2 < 2; ++b2) _Pragma("unroll") for (int jj = 0; jj < 4; ++jj) { const float p = __builtin_amdgcn_exp2f(s[h][g][b2][jj]); s[h][g][b2][jj] = p; ps += p; } \
            lrun[g] += ps; \
            u32x4 w; w.x = pk2(s[h][g][0][0], s[h][g][0][1]); w.y = pk2(s[h][g][0][2], s[h][g][0][3]); w.z = pk2(s[h][g][1][0], s[h][g][1][1]); w.w = pk2(s[h][g][1][2], s[h][g][1][3]); \
            pb[g][h] = __builtin_bit_cast(bf16x8, w); } } while (0)
#define AT_PV(h, d4) do { _Pragma("unroll") for (int dd = 0; dd < 4; ++dd) { \
                o[0][4 * (d4) + dd] = __builtin_amdgcn_mfma_f32_16x16x32_bf16(vf[dd], pb[0][h], o[0][4 * (d4) + dd], 0, 0, 0); o[1][4 * (d4) + dd] = __builtin_amdgcn_mfma_f32_16x16x32_bf16(vf[dd], pb[1][h], o[1][4 * (d4) + dd], 0, 0, 0); } } while (0)
            AT_RK(0, 0); AT_SB();
            AT_QK(0, 0); AT_SB();
            AT_RK(0, 1); AT_RV(0, 0); AT_SB();
            AT_QK(0, 1); AT_SB();
            AT_RK(1, 0); AT_SB();
            AT_SM(0); AT_SB();
            AT_QK(1, 0); AT_SB();
            AT_RK(1, 1); AT_SB();
            AT_PV(0, 0); AT_SB();
            AT_RV(0, 1); AT_SB();
            AT_QK(1, 1); AT_SB();
            AT_PV(0, 1); AT_SB();
            AT_RV(1, 0); AT_SB();
            AT_SM(1); AT_SB();
            AT_PV(1, 0); AT_SB();
            AT_RV(1, 1); AT_SB();
            AT_PV(1, 1);
#undef AT_SB
#undef AT_RK
#undef AT_RV
#undef AT_QK
#undef AT_SM
#undef AT_PV
        }
        asm volatile("s_waitcnt vmcnt(0)" ::: "memory");
        __syncthreads();
    }
#undef AT_STAGE
    float lt[2];
#pragma unroll
    for (int g = 0; g < 2; ++g) { float l = lrun[g] + __shfl_xor(lrun[g], 16); l += __shfl_xor(l, 32); lt[g] = l; }
    LAS f32x4* ob = (LAS f32x4*)lds; LAS float* mlb = (LAS float*)(lds + 65536);
    if (kh == 1) {
#pragma unroll
        for (int g = 0; g < 2; ++g) {
#pragma unroll
            for (int db = 0; db < 8; ++db) ob[((rg * 2 + g) * 8 + db) * 64 + lane] = o[g][db];
            mlb[(rg * 2 + g) * 64 + lane] = lt[g]; }
    }
    __syncthreads();
    if (kh == 0) {
        const int b = bh >> 3, h = bh & 7;
#pragma unroll
        for (int g = 0; g < 2; ++g) {
            const float inv = 1.0f / (lt[g] + mlb[(rg * 2 + g) * 64 + lane]);
            bf16* op = A2 + (size_t)(b * SEQ + R0 + 16 * g + fr) * DM + h * HDIM + 4 * fq;
#pragma unroll
            for (int db = 0; db < 8; ++db) { const f32x4 v = (o[g][db] + ob[((rg * 2 + g) * 8 + db) * 64 + lane]) * inv; u32x2 w; w.x = pk2(v[0], v[1]); w.y = pk2(v[2], v[3]); *(u32x2*)(op + 16 * db) = w; }
        }
    }
    __syncthreads();
}

#define XB_TMO      128
#define XB_XCNT(j)  (256  + 64 * (j))
#define XB_XSUB(j)  (1280 + 64 * (j))
#define XB_XGEN(j)  (2304 + 64 * (j))
#define XB_TOP      3328
#define XB_TOPGEN   3392
#define XCD_BAR_WORDS 3456
#define XB_SPIN_CAP (1u << 18)

__device__ __forceinline__ unsigned xb_ld(unsigned* p)              { return __hip_atomic_load(p, __ATOMIC_RELAXED, __HIP_MEMORY_SCOPE_AGENT); }
__device__ __forceinline__ unsigned xb_add(unsigned* p, unsigned v) { return __hip_atomic_fetch_add(p, v, __ATOMIC_RELAXED, __HIP_MEMORY_SCOPE_AGENT); }
__device__ __forceinline__ unsigned xb_xcc_id() { return (unsigned)__builtin_amdgcn_s_getreg((3 << 11) | 20) & 0xFu; }
#define XB_SPIN(cond, bar) do { unsigned _sp = 0; while (cond) { __builtin_amdgcn_s_sleep(1); \
    if ((++_sp & 255u) == 0u) { if (xb_ld(&(bar)[XB_TMO])) break; if (_sp > XB_SPIN_CAP) { atomicAdd(&(bar)[XB_TMO], 1u); break; } } } } while (0)

struct XcdBarrier {
    unsigned* bar; unsigned x;
    volatile LAS unsigned* st;
};

__device__ __forceinline__ XcdBarrier xcd_barrier_post(unsigned* bar, volatile LAS unsigned* st) {
    XcdBarrier b; b.bar = bar; b.x = xb_xcc_id(); b.st = st;
    if (threadIdx.x == 0) (void)xb_add(&bar[XB_XCNT(b.x)], 1u);
    return b;
}
__device__ __forceinline__ void xcd_barrier_complete(unsigned* bar, unsigned x, unsigned& nloc, unsigned& nx) {
    const unsigned G = gridDim.x * gridDim.y * gridDim.z;
    unsigned sum, cnt, mine, sp = 0u;
    for (;;) {
        sum = 0u; cnt = 0u; mine = 0u;
#pragma unroll
        for (unsigned j = 0; j < 16; ++j) { const unsigned c = xb_ld(&bar[XB_XCNT(j)]); sum += c; cnt += (c > 0u) ? 1u : 0u; mine = (j == x) ? c : mine; }
        if (sum == G) break;
        __builtin_amdgcn_s_sleep(1);
        if ((++sp & 255u) == 0u) { if (xb_ld(&bar[XB_TMO])) break; if (sp > XB_SPIN_CAP) { atomicAdd(&bar[XB_TMO], 1u); break; } }
    }
    nloc = mine > 0u ? mine : 1u; nx = cnt > 0u ? cnt : 1u;
}

__device__ __forceinline__ void xcd_barrier(const XcdBarrier& b) {
    asm volatile("s_waitcnt vmcnt(0)" ::: "memory");
    __syncthreads();
    if (threadIdx.x == 0) {
        unsigned* bar = b.bar;
        __builtin_amdgcn_s_waitcnt(0);
        unsigned nloc = b.st[0], nx = b.st[1];
        if (nloc == 0u) { xcd_barrier_complete(bar, b.x, nloc, nx); b.st[0] = nloc; b.st[1] = nx; }
        const unsigned old = xb_add(&bar[XB_XSUB(b.x)], 1u);
        const unsigned gen = old / nloc;
        if (old + 1u == (gen + 1u) * nloc) {
            __builtin_amdgcn_fence(__ATOMIC_RELEASE, "agent");
            asm volatile("s_waitcnt vmcnt(0)" ::: "memory");
            const unsigned og = xb_add(&bar[XB_TOP], 1u);
            const unsigned tg = og / nx;
            if (og + 1u == (tg + 1u) * nx) xb_add(&bar[XB_TOPGEN], 1u);
            else XB_SPIN(xb_ld(&bar[XB_TOPGEN]) == tg, bar);
            __builtin_amdgcn_fence(__ATOMIC_ACQUIRE, "agent");
            xb_add(&bar[XB_XGEN(b.x)], 1u);
            asm volatile("s_waitcnt vmcnt(0)" ::: "memory");
        } else {
            XB_SPIN(xb_ld(&bar[XB_XGEN(b.x)]) == gen, bar);
            __builtin_amdgcn_fence(__ATOMIC_ACQUIRE, "agent");
            asm volatile("s_waitcnt vmcnt(0)" ::: "memory");
        }
    }
    __syncthreads();
}

__global__ void __launch_bounds__(NTHREADS, 2) mk_fwd(Ptrs P) {
    extern __shared__ __attribute__((aligned(16))) unsigned char lds_raw[];
    LAS unsigned char* lds = (LAS unsigned char*)lds_raw;
    cg::grid_group grid = cg::this_grid();
    const int tid = threadIdx.x, lane = tid & 63, wave = __builtin_amdgcn_readfirstlane(tid >> 6);
    const int G = gridDim.x, blk = blockIdx.x;
    const int gw = blk * NWAVES + wave, NGW = G * NWAVES, gtid = blk * NTHREADS + tid, NGT = G * NTHREADS;
    unsigned char* ws = P.ws;
    if (ws == nullptr) grid.sync();
    volatile LAS unsigned* misc = (volatile LAS unsigned*)(lds + LDS_BYTES - 256);
    if (tid < 32) misc[tid] = 0u;
    __syncthreads();
    const XcdBarrier bar = xcd_barrier_post((unsigned*)(ws + WS_CTL), misc + 8);
    float* MOD = (float*)(ws + WS_MOD); float* LOGF = (float*)(ws + WS_LOGF); float* F2 = (float*)(ws + WS_F2);
    bf16* H = (bf16*)(ws + WS_H); bf16* ACT = (bf16*)(ws + WS_ACT); bf16* A2 = (bf16*)(ws + WS_A2);
    const float* x = P.in[0]; float* out = P.out;
#ifndef REP_SYNC
#define REP_SYNC 1
#endif
#ifndef REP_P0
#define REP_P0 1
#endif
#ifndef REP_ATT
#define REP_ATT 1
#endif
#define GRID_SYNC() do { for (int _r = 0; _r < REP_SYNC; ++_r) xcd_barrier(bar); } while (0)

    for (int rep = 0; rep < REP_P0; ++rep) {
    p0_mod(P.in[1], P.in[2], P.in[3], MOD, (LAS float*)lds, G, blk, tid);
    p0_convert<0>(P, (LAS float*)(lds + wave * 16384), gw, NGW, lane);
    __syncthreads(); }
    GRID_SYNC();
    norm_mod_phase<false>(x, H, P.in[4], MOD + 0 * DM, MOD + 1 * DM, nullptr, nullptr, nullptr, gw, NGW, lane);
    GRID_SYNC();
    { pg8::Gemm g{H, (const bf16*)(ws + WS_W1I), DM, DM, DM, 0}; pg8::StaticOrder S; S.init(MTOK, NFF2, G, blk); pg8::EpiSwiglu E{ACT, DFF};
      pg8::gemm_phase<pg8::EpiSwiglu, pg8::StaticOrder, true, true>(lds, g, S, E);
      const int nfull = (MTOK / 256) * (NFF2 / 256) / G, nrem = (MTOK / 256) * (NFF2 / 256) - nfull * G, nidle = G - nrem;
      if (nrem > 0 && blk >= nrem) { __syncthreads(); p0_convert<1>(P, (LAS float*)(lds + wave * 16384), (blk - nrem) * NWAVES + wave, nidle * NWAVES, lane); }
      else if (nrem == 0) { __syncthreads(); p0_convert<1>(P, (LAS float*)(lds + wave * 16384), gw, NGW, lane); } }
    GRID_SYNC();
    { pg8::Gemm g{ACT, (const bf16*)(ws + WS_W1O), DFF, DFF, DFF, 0}; pg8::StaticOrder S; S.init(MTOK, DM, G, blk); pg8::EpiResid E{x, out, DM, MOD + 2 * DM, NMOD, SEQ, 0.5f};
      pg8::gemm_phase<pg8::EpiResid, pg8::StaticOrder, true, true>(lds, g, S, E); }
    GRID_SYNC();
    { LAS float* wf = (LAS float*)lds;
      for (int i = tid; i < DM * 8; i += NTHREADS) { const int k = i >> 3, h = i & 7; wf[h * DM + k] = P.in[8][(size_t)k * DINP + 3 * DATT + h]; }
      __syncthreads();
      norm_mod_phase<true>(out, H, P.in[7], MOD + 3 * DM, MOD + 4 * DM, wf, P.in[9], LOGF, gw, NGW, lane); }
    GRID_SYNC();
    if (blk < NBATCH * NHEAD) cumsum_bh(LOGF, F2, blk, (LAS double*)lds, tid, wave, lane);
    { pg8::Gemm g{H, (const bf16*)(ws + WS_WIN), DM, DM, DM, 0}; pg8::StaticOrder S; S.init(MTOK, 4 * DATT, G, blk); pg8::EpiBf16 E{(bf16*)(ws + WS_QRAW), DATT, DATT, (WS_KRAW - WS_QRAW) / 2};
      pg8::gemm_phase<pg8::EpiBf16, pg8::StaticOrder, true, true>(lds, g, S, E); }
    GRID_SYNC();
    prep_phase(P, lds, gw, NGW, wave, lane, gtid, NGT);
    GRID_SYNC();
    float cref;
    { float gq = fmaxf(fabsf(P.in[10][lane]), fabsf(P.in[10][lane + 64])), gk = fmaxf(fabsf(P.in[11][lane]), fabsf(P.in[11][lane + 64]));
#pragma unroll
      for (int o = 1; o < 64; o <<= 1) { gq = fmaxf(gq, __shfl_xor(gq, o)); gk = fmaxf(gk, __shfl_xor(gk, o)); }
      cref = 128.0f * 0.08838834764831845f * 1.4426950408889634f * 1.02f * gq * gk + 0.5f; }
    for (int rep = 0; rep < REP_ATT; ++rep)
    for (int it2 = 2 * blk; it2 < 512; it2 += 2 * G)
        for (int u = 0; u < 2; ++u) { const int x = (it2 >> 1) & 7, j = it2 >> 4;
            attn_unit2(lds, (const bf16*)(ws + WS_QN), (const bf16*)(ws + WS_KN), (const bf16*)(ws + WS_VT), F2, A2, cref, u ? x + 8 : x, u ? 31 - j : j, tid, wave, lane); }
    { pg8::Gemm g{(const bf16*)(ws + WS_POOLED), (const bf16*)(ws + WS_WPOOL), 1024, 256, 256, 512}; pg8::StaticOrder S; S.init(MTOK, 1024, G, blk); pg8::EpiBf16 E{A2 + 1024, DM, 0, 0};
      pg8::gemm_phase<pg8::EpiBf16, pg8::StaticOrder, true, true>(lds, g, S, E); }
    GRID_SYNC();
    { pg8::Gemm g{A2, (const bf16*)(ws + WS_WOUT), DM, DM, DM, 0}; pg8::StaticOrder S; S.init(MTOK, DM, G, blk); pg8::EpiResid E{out, out, DM, MOD + 5 * DM, NMOD, SEQ, 1.0f};
      pg8::gemm_phase<pg8::EpiResid, pg8::StaticOrder, true, true>(lds, g, S, E); }
    GRID_SYNC();
    norm_mod_phase<false>(out, H, P.in[15], MOD + 6 * DM, MOD + 7 * DM, nullptr, nullptr, nullptr, gw, NGW, lane);
    GRID_SYNC();
    { pg8::Gemm g{H, (const bf16*)(ws + WS_W2I), DM, DM, DM, 0}; pg8::StaticOrder S; S.init(MTOK, NFF2, G, blk); pg8::EpiSwiglu E{ACT, DFF};
      pg8::gemm_phase<pg8::EpiSwiglu, pg8::StaticOrder, true, true>(lds, g, S, E); }
    GRID_SYNC();
    { pg8::Gemm g{ACT, (const bf16*)(ws + WS_W2O), DFF, DFF, DFF, 0}; pg8::StaticOrder S; S.init(MTOK, DM, G, blk); pg8::EpiResid E{out, out, DM, MOD + 8 * DM, NMOD, SEQ, 0.5f};
      pg8::gemm_phase<pg8::EpiResid, pg8::StaticOrder, true, true>(lds, g, S, E); }
    GRID_SYNC();
    final_norm_phase(out, P.in[18], gw, NGW, lane);
}

extern "C" void kernel_launch(void* const* d_in, const int* in_sizes, int n_in, void* d_out, int out_size, void* d_ws, size_t ws_size, hipStream_t stream) {
    static int grid = 0;
    if (grid == 0) {
        if (n_in != 19 || out_size != MTOK * DM || ws_size < WS_END) { fprintf(stderr, "kernel_launch: unexpected shapes (n_in %d, out %d, ws %zu)\n", n_in, out_size, ws_size); grid = -1; return; }
        int dev = 0, cus = 0, per_cu = 0;
        hipGetDevice(&dev); hipDeviceGetAttribute(&cus, hipDeviceAttributeMultiprocessorCount, dev);
        if (hipFuncSetAttribute((const void*)mk_fwd, hipFuncAttributeMaxDynamicSharedMemorySize, LDS_BYTES) != hipSuccess) { fprintf(stderr, "kernel_launch: hipFuncSetAttribute failed\n"); grid = -1; return; }
        if (hipOccupancyMaxActiveBlocksPerMultiprocessor(&per_cu, (const void*)mk_fwd, NTHREADS, LDS_BYTES) != hipSuccess || per_cu < 1) { fprintf(stderr, "kernel_launch: occupancy query failed (%d)\n", per_cu); (void)hipGetLastError(); per_cu = 1; }
        grid = cus * (per_cu > 1 ? 1 : per_cu);
        if (grid < 1) grid = -1;
    }
    if (grid < 0) return;
    if (hipMemsetAsync((char*)d_ws + WS_CTL, 0, 16384, stream) != hipSuccess) { fprintf(stderr, "kernel_launch: memset failed\n"); return; }
    Ptrs p{};
    for (int i = 0; i < 19; ++i) p.in[i] = (const float*)d_in[i];
    p.out = (float*)d_out; p.ws = (unsigned char*)d_ws;
    void* args[] = {&p};
    hipError_t e = hipLaunchCooperativeKernel((const void*)mk_fwd, dim3(grid), dim3(NTHREADS), args, LDS_BYTES, stream);
    if (e != hipSuccess) fprintf(stderr, "cooperative launch failed: %s (grid %d)\n", hipGetErrorString(e), grid);
}
```
